# Optimizing an MI355X kernel written in HIP

```python
import math
import jax, jax.numpy as jnp
from jax import lax
import numpy as np

D_MODEL = 1024
BATCH = 8
SEQ = 4096
DEPTH = 2

MEM_LEN = 256
EPS = 1e-6
POS_OFFSET_MAX = 1024

N_GROUPS_MIX = 4
GROUP_W = 256
D_MIX = N_GROUPS_MIX * GROUP_W

MLA_HEADS = 4
MLA_Q_RANK = 256
MLA_KV_RANK = 128
MLA_NOPE = 64
MLA_ROPE = 32
MLA_QK_DIM = MLA_NOPE + MLA_ROPE
MLA_V = GROUP_W // MLA_HEADS
ROPE_THETA = 10000.0
Q_BLOCK = 128

POOL_WINDOWS = (2, 4, 8, 16)
POOL_GROUP = GROUP_W // len(POOL_WINDOWS)

SWA_HEADS = 4
SWA_KV_HEADS = 2
SWA_HEAD_DIM = GROUP_W // SWA_HEADS
SWA_WINDOW = 128

CONV_W = 3
CONV_CH = GROUP_W

A_COLS = MLA_Q_RANK + MLA_KV_RANK + MLA_ROPE
B_COLS = GROUP_W
C_COLS = (SWA_HEADS + 2 * SWA_KV_HEADS) * SWA_HEAD_DIM
D_COLS = 3 * CONV_CH
IN_COLS = A_COLS + B_COLS + C_COLS + D_COLS

XA_HEADS = 4
XA_HEAD_DIM = 64

N_EXPERT_GROUPS = 4
EXPERTS_PER_GROUP = 8
N_EXPERTS = N_EXPERT_GROUPS * EXPERTS_PER_GROUP
TOP_K = 2
D_EXPERT = 256
MOE_BLOCK = 256

kernel_name = "hybrid_parallel_heads_mla_pool_swa_conv_hmoe"


def rms_norm(x, gain):
    xf = x.astype(jnp.float32)
    y = xf * lax.rsqrt(jnp.mean(xf * xf, axis=-1, keepdims=True) + EPS)
    return (y * gain.astype(jnp.float32)).astype(x.dtype)


def rotary(x, positions):
    half = x.shape[-1] // 2
    inv_freq = ROPE_THETA ** (-jnp.arange(half, dtype=jnp.float32) / half)
    ang = positions.astype(jnp.float32)[..., None] * inv_freq
    cos = jnp.cos(ang)[:, :, None, :]
    sin = jnp.sin(ang)[:, :, None, :]
    xf = x.astype(jnp.float32)
    x1, x2 = xf[..., :half], xf[..., half:]
    return jnp.concatenate([x1 * cos - x2 * sin, x2 * cos + x1 * sin], axis=-1).astype(x.dtype)


def causal_attention_qblocks(q, k, v, scale):
    B, S, H, dq = q.shape
    nb = S // Q_BLOCK
    qb = q.reshape(B, nb, Q_BLOCK, H, dq).transpose(1, 0, 2, 3, 4)
    key_pos = jnp.arange(S)

    def one_block(args):
        qi, bi = args
        s = jnp.einsum('bqhd,bkhd->bhqk', qi, k, preferred_element_type=jnp.float32) * scale
        q_pos = bi * Q_BLOCK + jnp.arange(Q_BLOCK)
        mask = key_pos[None, :] <= q_pos[:, None]
        s = jnp.where(mask[None, None], s, -jnp.inf)
        p = jax.nn.softmax(s, axis=-1)
        return jnp.einsum('bhqk,bkhd->bqhd', p.astype(v.dtype), v)

    out = lax.map(one_block, (qb, jnp.arange(nb)))
    return out.transpose(1, 0, 2, 3, 4).reshape(B, S, H, v.shape[-1])


def mla_mixer(u, positions, g_cq, w_uq, g_ckv, w_ukv, g_q, g_k):
    B, S, _ = u.shape
    c_q = u[..., :MLA_Q_RANK]
    c_kv = u[..., MLA_Q_RANK:MLA_Q_RANK + MLA_KV_RANK]
    k_rope = u[..., MLA_Q_RANK + MLA_KV_RANK:]
    q = (rms_norm(c_q, g_cq) @ w_uq).reshape(B, S, MLA_HEADS, MLA_QK_DIM)
    kv = (rms_norm(c_kv, g_ckv) @ w_ukv).reshape(B, S, MLA_HEADS, MLA_NOPE + MLA_V)
    k = jnp.concatenate(
        [kv[..., :MLA_NOPE], jnp.broadcast_to(k_rope[:, :, None, :], (B, S, MLA_HEADS, MLA_ROPE))], axis=-1)
    v = kv[..., MLA_NOPE:]
    q = rms_norm(q, g_q)
    k = rms_norm(k, g_k)
    q = jnp.concatenate([q[..., :MLA_NOPE], rotary(q[..., MLA_NOPE:], positions)], axis=-1)
    k = jnp.concatenate([k[..., :MLA_NOPE], rotary(k[..., MLA_NOPE:], positions)], axis=-1)
    o = causal_attention_qblocks(q, k, v, MLA_QK_DIM ** -0.5)
    return o.reshape(B, S, MLA_HEADS * MLA_V)


def pool_mixer(u, w_pool, pool_scale):
    B, S, C = u.shape
    uf = u.astype(jnp.float32)
    cs = jnp.pad(jnp.cumsum(uf, axis=1), ((0, 0), (1, 0), (0, 0)))
    t = jnp.arange(S)
    outs = []
    for gi, w in enumerate(POOL_WINDOWS):
        lo, hi = gi * POOL_GROUP, (gi + 1) * POOL_GROUP
        csg = cs[..., lo:hi]
        start = jnp.maximum(t + 1 - w, 0)
        win_sum = csg[:, 1:] - csg[:, start]
        count = jnp.minimum(t + 1, w).astype(jnp.float32)
        outs.append(win_sum / count[None, :, None] - uf[..., lo:hi])
    pooled = jnp.concatenate(outs, axis=-1).astype(u.dtype).reshape(B, S, len(POOL_WINDOWS), POOL_GROUP)
    y = jnp.einsum('bsgc,gcd->bsgd', pooled, w_pool).reshape(B, S, C)
    return y * pool_scale


def swa_mixer(u, g_q, g_k, sinks):
    B, S, _ = u.shape
    H, KV, dh, W = SWA_HEADS, SWA_KV_HEADS, SWA_HEAD_DIM, SWA_WINDOW
    G = H // KV
    nb = S // W
    q = rms_norm(u[..., :H * dh].reshape(B, S, KV, G, dh), g_q)
    k = rms_norm(u[..., H * dh:(H + KV) * dh].reshape(B, S, KV, dh), g_k)
    v = u[..., (H + KV) * dh:].reshape(B, S, KV, dh)
    qb = q.reshape(B, nb, W, KV, G, dh)

    def band(z):
        zb = z.reshape(B, nb, W, KV, dh)
        prev = jnp.pad(zb, ((0, 0), (1, 0), (0, 0), (0, 0), (0, 0)))[:, :-1]
        return jnp.concatenate([prev, zb], axis=2)

    kb, vb = band(k), band(v)
    s = jnp.einsum('bnqkgd,bnjkd->bnkgqj', qb, kb, preferred_element_type=jnp.float32) * (dh ** -0.5)
    qi = jnp.arange(W)[:, None]
    kj = jnp.arange(2 * W)[None, :]
    diff = W + qi - kj
    in_win = (diff >= 0) & (diff < W)
    key_ok = (jnp.arange(nb)[:, None] * W + kj - W) >= 0
    mask = in_win[None] & key_ok[:, None, :]
    s = jnp.where(mask[None, :, None, None], s, -jnp.inf)
    sink = jnp.broadcast_to(sinks.reshape(KV, G).astype(jnp.float32)[None, None, :, :, None, None],
                            s.shape[:-1] + (1,))
    p = jax.nn.softmax(jnp.concatenate([s, sink], axis=-1), axis=-1)[..., :2 * W]
    o = jnp.einsum('bnkgqj,bnjkd->bnqkgd', p.astype(vb.dtype), vb)
    return o.reshape(B, S, H * dh)


def conv_mixer(u, conv_w, conv_b):
    b_gate = u[..., :CONV_CH]
    c_gate = u[..., CONV_CH:2 * CONV_CH]
    h = u[..., 2 * CONV_CH:]
    z = c_gate * h
    conv = lax.conv_general_dilated(
        z, conv_w.reshape(CONV_W, 1, CONV_CH), window_strides=(1,), padding=[(CONV_W - 1, 0)],
        dimension_numbers=('NWC', 'WIO', 'NWC'), feature_group_count=CONV_CH)
    return b_gate * (conv + conv_b)


def cross_attention(h, m, w_q, w_kv, g_q, g_k, w_o):
    B, S, _ = h.shape
    M = m.shape[1]
    q = rms_norm((h @ w_q).reshape(B, S, XA_HEADS, XA_HEAD_DIM), g_q)
    kv = (m @ w_kv).reshape(B, M, 2, XA_HEADS, XA_HEAD_DIM)
    k = rms_norm(kv[:, :, 0], g_k)
    v = kv[:, :, 1]
    s = jnp.einsum('bshd,bmhd->bhsm', q, k, preferred_element_type=jnp.float32) * (XA_HEAD_DIM ** -0.5)
    p = jax.nn.softmax(s, axis=-1)
    o = jnp.einsum('bhsm,bmhd->bshd', p.astype(v.dtype), v).reshape(B, S, XA_HEADS * XA_HEAD_DIM)
    return o @ w_o


def hier_moe(h, w_group, b_group, w_expert, b_expert, w_gate, w_up, w_down):
    B, S, D = h.shape
    N = B * S
    t = h.reshape(N, D)
    rows = jnp.arange(N)
    g_logits = (t @ w_group).astype(jnp.float32) + b_group.astype(jnp.float32)
    g_prob = jax.nn.softmax(g_logits, axis=-1)
    g_idx = jnp.argmax(g_logits, axis=-1)
    g_w = g_prob[rows, g_idx]
    e_logits = ((t @ w_expert).astype(jnp.float32) + b_expert.astype(jnp.float32)).reshape(
        N, N_EXPERT_GROUPS, EXPERTS_PER_GROUP)
    e_prob = jax.nn.softmax(e_logits[rows, g_idx], axis=-1)
    top_p, top_i = lax.top_k(e_prob, TOP_K)
    top_p = top_p / jnp.sum(top_p, axis=-1, keepdims=True)
    weights = g_w[:, None] * top_p
    expert_id = g_idx[:, None] * EXPERTS_PER_GROUP + top_i
    A = N * TOP_K
    flat_e = expert_id.reshape(A)
    flat_w = weights.reshape(A)
    flat_tok = jnp.repeat(rows, TOP_K)
    order = jnp.argsort(flat_e)
    se, stok, sw = flat_e[order], flat_tok[order], flat_w[order]
    counts = jnp.bincount(flat_e, length=N_EXPERTS)
    starts = jnp.cumsum(counts) - counts
    padded = ((counts + MOE_BLOCK - 1) // MOE_BLOCK) * MOE_BLOCK
    pends = jnp.cumsum(padded)
    pstarts = pends - padded
    dest = pstarts[se] + (jnp.arange(A) - starts[se])
    P = ((A + N_EXPERTS * (MOE_BLOCK - 1) + MOE_BLOCK - 1) // MOE_BLOCK) * MOE_BLOCK
    n_blocks = P // MOE_BLOCK
    tok_buf = jnp.zeros((P,), jnp.int32).at[dest].set(stok.astype(jnp.int32))
    w_buf = jnp.zeros((P,), jnp.float32).at[dest].set(sw)
    blk_expert = jnp.minimum(
        jnp.searchsorted(pends, jnp.arange(n_blocks) * MOE_BLOCK, side='right'), N_EXPERTS - 1)

    def expert_block(args):
        tok, wt, e = args
        xb = t[tok]
        y = (jax.nn.silu(xb @ w_gate[e]) * (xb @ w_up[e])) @ w_down[e]
        return y * wt[:, None].astype(y.dtype)

    ys = lax.map(expert_block, (tok_buf.reshape(n_blocks, MOE_BLOCK),
                                w_buf.reshape(n_blocks, MOE_BLOCK), blk_expert))
    out = jax.ops.segment_sum(ys.reshape(P, D), tok_buf, num_segments=N)
    return out.reshape(B, S, D)


def setup_inputs(seed: int = 0) -> dict:
    key = jax.random.key(seed)
    ks = iter(jax.random.split(key, 64))
    f32 = jnp.float32
    L = DEPTH

    def nrm(shape, scale):
        return jax.random.normal(next(ks), shape, f32) * scale

    def gain(shape):
        return 1.0 + 0.05 * jax.random.normal(next(ks), shape, f32)

    x = nrm((BATCH, SEQ, D_MODEL), 1.0)
    mem = nrm((BATCH, MEM_LEN, D_MODEL), 1.0)
    positions = jnp.arange(SEQ, dtype=jnp.int32)[None, :] + jax.random.randint(
        next(ks), (BATCH, 1), 0, POS_OFFSET_MAX, dtype=jnp.int32)
    return {
        "x": x,
        "mem": mem,
        "positions": positions,
        "norm_mix": gain((L, D_MODEL)),
        "w_in": nrm((L, D_MODEL, IN_COLS), D_MODEL ** -0.5),
        "mla_g_cq": gain((L, MLA_Q_RANK)),
        "mla_w_uq": nrm((L, MLA_Q_RANK, MLA_HEADS * MLA_QK_DIM), MLA_Q_RANK ** -0.5),
        "mla_g_ckv": gain((L, MLA_KV_RANK)),
        "mla_w_ukv": nrm((L, MLA_KV_RANK, MLA_HEADS * (MLA_NOPE + MLA_V)), MLA_KV_RANK ** -0.5),
        "mla_g_q": gain((L, MLA_QK_DIM)),
        "mla_g_k": gain((L, MLA_QK_DIM)),
        "pool_w": nrm((L, len(POOL_WINDOWS), POOL_GROUP, POOL_GROUP), POOL_GROUP ** -0.5),
        "pool_scale": gain((L, GROUP_W)),
        "swa_g_q": gain((L, SWA_HEAD_DIM)),
        "swa_g_k": gain((L, SWA_HEAD_DIM)),
        "swa_sinks": nrm((L, SWA_HEADS), 0.5),
        "conv_w": nrm((L, CONV_W, CONV_CH), CONV_W ** -0.5),
        "conv_b": nrm((L, CONV_CH), 0.02),
        "mix_out_norm": gain((L, D_MIX)),
        "w_mix_out": nrm((L, D_MIX, D_MODEL), D_MIX ** -0.5),
        "norm_xa": gain((L, D_MODEL)),
        "norm_mem": gain((L, D_MODEL)),
        "xa_w_q": nrm((L, D_MODEL, XA_HEADS * XA_HEAD_DIM), D_MODEL ** -0.5),
        "xa_w_kv": nrm((L, D_MODEL, 2 * XA_HEADS * XA_HEAD_DIM), D_MODEL ** -0.5),
        "xa_g_q": gain((L, XA_HEAD_DIM)),
        "xa_g_k": gain((L, XA_HEAD_DIM)),
        "xa_w_o": nrm((L, XA_HEADS * XA_HEAD_DIM, D_MODEL), (XA_HEADS * XA_HEAD_DIM) ** -0.5),
        "norm_ffn": gain((L, D_MODEL)),
        "w_group": nrm((L, D_MODEL, N_EXPERT_GROUPS), D_MODEL ** -0.5),
        "b_group": nrm((L, N_EXPERT_GROUPS), 0.01),
        "w_expert": nrm((L, D_MODEL, N_EXPERTS), D_MODEL ** -0.5),
        "b_expert": nrm((L, N_EXPERTS), 0.01),
        "w_gate": nrm((L, N_EXPERTS, D_MODEL, D_EXPERT), D_MODEL ** -0.5),
        "w_up": nrm((L, N_EXPERTS, D_MODEL, D_EXPERT), D_MODEL ** -0.5),
        "w_down": nrm((L, N_EXPERTS, D_EXPERT, D_MODEL), D_EXPERT ** -0.5),
    }


def reference(x, mem, positions, norm_mix, w_in, mla_g_cq, mla_w_uq, mla_g_ckv, mla_w_ukv,
              mla_g_q, mla_g_k, pool_w, pool_scale, swa_g_q, swa_g_k, swa_sinks, conv_w, conv_b,
              mix_out_norm, w_mix_out, norm_xa, norm_mem, xa_w_q, xa_w_kv, xa_g_q, xa_g_k, xa_w_o,
              norm_ffn, w_group, b_group, w_expert, b_expert, w_gate, w_up, w_down):
    B, S, _ = x.shape
    for l in range(DEPTH):
        h = rms_norm(x, norm_mix[l])
        u = h @ w_in[l]
        c0 = A_COLS
        c1 = c0 + B_COLS
        c2 = c1 + C_COLS
        y_a = mla_mixer(u[..., :c0], positions, mla_g_cq[l], mla_w_uq[l], mla_g_ckv[l],
                        mla_w_ukv[l], mla_g_q[l], mla_g_k[l])
        y_b = pool_mixer(u[..., c0:c1], pool_w[l], pool_scale[l])
        y_c = swa_mixer(u[..., c1:c2], swa_g_q[l], swa_g_k[l], swa_sinks[l])
        y_d = conv_mixer(u[..., c2:], conv_w[l], conv_b[l])
        y = jnp.stack([y_a, y_b, y_c, y_d], axis=2)
        y = rms_norm(y, mix_out_norm[l].reshape(N_GROUPS_MIX, GROUP_W)).reshape(B, S, D_MIX)
        x = x + y @ w_mix_out[l]
        h = rms_norm(x, norm_xa[l])
        m = rms_norm(mem, norm_mem[l])
        x = x + cross_attention(h, m, xa_w_q[l], xa_w_kv[l], xa_g_q[l], xa_g_k[l], xa_w_o[l])
        h = rms_norm(x, norm_ffn[l])
        x = x + hier_moe(h, w_group[l], b_group[l], w_expert[l], b_expert[l],
                         w_gate[l], w_up[l], w_down[l])
    return x
```

```cpp
#include <hip/hip_runtime.h>
#include <cstdio>
#include <cstdint>
#ifndef PROBE_MASK
#define PROBE_MASK 0
#endif
#define REP(k) _Pragma("unroll 1") for (int rep_ = 0; rep_ < (((PROBE_MASK) >> (k)) & 1) + 1; ++rep_)
__device__ __forceinline__ int tid_now() { int t = threadIdx.x; asm volatile("" : "+v"(t)); return t; }
struct Args { const void* in[35]; float* out; unsigned char* ws; int G; int pad; };
__device__ __forceinline__ const void* kernarg_ptr(int i) { const char* p = (const char*)__builtin_amdgcn_kernarg_segment_ptr(); asm volatile("" : "+s"(p));
    const unsigned long long v = *(const unsigned long long*)(p + 8 * i);
    const unsigned lo = __builtin_amdgcn_readfirstlane((unsigned)v), hi = __builtin_amdgcn_readfirstlane((unsigned)(v >> 32));
    return (const void*)(const __attribute__((address_space(1))) void*)(((unsigned long long)hi << 32) | lo); }
#define ARGP(i) kernarg_ptr(i)
#define ARG_OUT ((float*)kernarg_ptr(35))
#define ARG_WS ((unsigned char*)kernarg_ptr(36))
__device__ __forceinline__ int kernarg_G() { const char* p = (const char*)__builtin_amdgcn_kernarg_segment_ptr(); asm volatile("" : "+s"(p)); return __builtin_amdgcn_readfirstlane(*(const int*)(p + 8 * 37)); }
namespace pg8 {
#define PG8_LAS __attribute__((address_space(3)))
typedef unsigned short bf16_t;
typedef short bf16x8 __attribute__((ext_vector_type(8)));
typedef float f32x4 __attribute__((ext_vector_type(4)));
typedef unsigned u32x4 __attribute__((ext_vector_type(4)));
constexpr int BM = 256, BK = 64, HALF = 128, HTB = HALF * BK * 2  , STAGE_BYTES = 8 * HTB, NXCD = 8, WGM = 8;

__host__ __device__ __forceinline__ int lds_byte(int r, int c) { const int st = (r >> 4) * 2 + (c >> 5), rr = r & 15, cc = c & 31, ob = rr * 64 + cc * 2; return st * 1024 + (ob ^ (((ob >> 9) & 1) << 5)); }
__host__ __device__ __forceinline__ void stage_rc(int b, int& R, int& C) { const int st = b / 1024, sb = b % 1024, swz = sb ^ (((sb >> 9) & 1) << 5); R = (st >> 1) * 16 + swz / 64; C = (st & 1) * 32 + (swz % 64) / 2; }
__host__ __device__ __forceinline__ int perm32(int rho) { const int n = rho >> 4, i = rho & 15; return 8 * (i >> 2) + 4 * n + (i & 3); }

struct Unit { int pm, pn; };
struct Gemm { const bf16_t* A; const bf16_t* Bt; int M, N, K, lda, ldb; };

struct StaticOrder {
    int nM, nN, nwg, G, c;
    __host__ __device__ void init(int M, int N, int G_, int c_) { nM = M / BM; nN = N / BM; nwg = nM * nN; G = G_; c = c_; }
    __device__ __forceinline__ bool next(int i, Unit& u) const {
        const long L = (long)i * G + c; if (L >= nwg) return false;
        int wgid = (int)L; { const int q = nwg / NXCD, r = nwg % NXCD, xcd = wgid % NXCD, off = wgid / NXCD; wgid = (xcd < r ? xcd * (q + 1) : r * (q + 1) + (xcd - r) * q) + off; }
        const int nig = WGM * nN, gid = wgid / nig, fm = gid * WGM, gsz = (nM - fm) < WGM ? (nM - fm) : WGM;
        u.pm = __builtin_amdgcn_readfirstlane(fm + ((wgid % nig) % gsz)); u.pn = __builtin_amdgcn_readfirstlane((wgid % nig) / gsz); return true;
    }
    __device__ __forceinline__ void a_ready(const Unit&) const {}
    __device__ __forceinline__ void done(const Unit&) const {}
};


__device__ __forceinline__ void st_wt16(const void* p, u32x4 v) { asm volatile("global_store_dwordx4 %0, %1, off sc1\n\ts_nop 2" :: "v"(p), "v"(v) : "memory"); }
__device__ __forceinline__ void flag_arrive(unsigned* f, int lane) { asm volatile("s_waitcnt vmcnt(0)" ::: "memory"); if (lane == 0) (void)__hip_atomic_fetch_add(f, 1u, __ATOMIC_RELAXED, __HIP_MEMORY_SCOPE_AGENT); }
__device__ __forceinline__ void flag_wait(unsigned* f, unsigned need, int lane) {
    if (lane == 0) { unsigned sp = 0u; while (__hip_atomic_load(f, __ATOMIC_RELAXED, __HIP_MEMORY_SCOPE_AGENT) < need) { __builtin_amdgcn_s_sleep(2); if (++sp > (1u << 22)) break; } }
    __builtin_amdgcn_fence(__ATOMIC_ACQUIRE, "agent");
}
__device__ __forceinline__ void flag_wait_wg(unsigned* f, unsigned need) {
    if (threadIdx.x == 0) { unsigned sp = 0u; while (__hip_atomic_load(f, __ATOMIC_RELAXED, __HIP_MEMORY_SCOPE_AGENT) < need) { __builtin_amdgcn_s_sleep(2); if (++sp > (1u << 22)) break; }
        __builtin_amdgcn_fence(__ATOMIC_ACQUIRE, "agent"); asm volatile("s_waitcnt vmcnt(0)" ::: "memory"); }
    __syncthreads();
}
struct StaticOrderPub : StaticOrder { unsigned* flg; int lane;
    __device__ __forceinline__ void done(const Unit& u) const { flag_arrive(&flg[64 * u.pm], lane); } };
struct PairOrder { int pm, pn0;
    __device__ __forceinline__ bool next(int i, Unit& u) const { if (i >= 2) return false; u.pm = pm; u.pn = pn0 + i; return true; }
    __device__ __forceinline__ void a_ready(const Unit&) const {}
    __device__ __forceinline__ void done(const Unit&) const {} };

__device__ __forceinline__ unsigned cvt_pk_bf16(float lo, float hi) { unsigned r; asm volatile("v_cvt_pk_bf16_f32 %0, %1, %2" : "=v"(r) : "v"(lo), "v"(hi)); return r; }
__device__ __forceinline__ float sumsq4(f32x4 v) { return (v[0] * v[0] + v[1] * v[1]) + (v[2] * v[2] + v[3] * v[3]); }
__device__ __forceinline__ u32x4 pack8(f32x4 v0, f32x4 v1) { u32x4 w; w.x = cvt_pk_bf16(v0[0], v0[1]); w.y = cvt_pk_bf16(v0[2], v0[3]); w.z = cvt_pk_bf16(v1[0], v1[1]); w.w = cvt_pk_bf16(v1[2], v1[3]); return w; }

struct EpiU {
    static constexpr bool PERM = true, AFTER_DRAIN = false, KHOOK = false;
    bf16_t* O; int ldc; float* statq; float* statkv; const float* xss; float eps; int Mrows;
    __device__ __forceinline__ void operator()(const f32x4 (&acc)[2][2][4][2], const Unit& u, int wr, int wc, int fr, int fq) const {
        const int row0 = u.pm * BM + wr * 64 + fr; const int col0 = u.pn * BM + wc * 32 + 8 * fq;
#pragma unroll
        for (int ai = 0; ai < 2; ++ai)
#pragma unroll
            for (int m = 0; m < 4; ++m) { const int row = row0 + ai * HALF + m * 16; bf16_t* rowp = O + (size_t)row * ldc + col0;
                const float r = __builtin_amdgcn_rsqf(xss[(size_t)row * 16] * (1.0f / 1024.0f) + eps);
                const f32x4 v00 = acc[ai][0][m][0] * r, v01 = acc[ai][0][m][1] * r, v10 = acc[ai][1][m][0] * r, v11 = acc[ai][1][m][1] * r;
                *(u32x4*)(rowp) = pack8(v00, v01); *(u32x4*)(rowp + HALF) = pack8(v10, v11);
                if (u.pn < 2) {
                    float s = sumsq4(v00) + sumsq4(v01);
                    if (u.pn == 0) s += sumsq4(v10) + sumsq4(v11);
                    s += __shfl_xor(s, 16); s += __shfl_xor(s, 32);
                    if (fq == 0) { float* st = (u.pn == 0) ? statq : statkv; st[(size_t)row * 4 + wc] = s; }
                } }
    }
};
struct EpiScaleBf16 {
    static constexpr bool PERM = true, AFTER_DRAIN = false, KHOOK = false;
    bf16_t* O; int ldc; const float* st0; const float* st1; int split_pn, np0, np1; float inv0, inv1, eps; int Mrows;
    __device__ __forceinline__ void operator()(const f32x4 (&acc)[2][2][4][2], const Unit& u, int wr, int wc, int fr, int fq) const {
        const int row0 = u.pm * BM + wr * 64 + fr; const int col0 = u.pn * BM + wc * 32 + 8 * fq;
        const bool first = u.pn < split_pn; const float* st = first ? st0 : st1; const int np = first ? np0 : np1; const float inv = first ? inv0 : inv1;
#pragma unroll
        for (int ai = 0; ai < 2; ++ai)
#pragma unroll
            for (int m = 0; m < 4; ++m) { const int row = row0 + ai * HALF + m * 16; float s = 0.f;
                for (int i = 0; i < np; i += 4) { const f32x4 p4 = *(const f32x4*)(st + (size_t)row * np + i); s += (p4[0] + p4[1]) + (p4[2] + p4[3]); }
                const float r = __builtin_amdgcn_rsqf(s * inv + eps);
                bf16_t* rowp = O + (size_t)row * ldc + col0;
#pragma unroll
                for (int bj = 0; bj < 2; ++bj) *(u32x4*)(rowp + bj * HALF) = pack8(acc[ai][bj][m][0] * r, acc[ai][bj][m][1] * r); }
    }
};
struct EpiScaleBf16WT {
    static constexpr bool PERM = true, AFTER_DRAIN = false, KHOOK = false;
    bf16_t* O; int ldc; const float* st0; const float* st1; int split_pn, np0, np1; float inv0, inv1, eps; int Mrows;
    __device__ __forceinline__ void operator()(const f32x4 (&acc)[2][2][4][2], const Unit& u, int wr, int wc, int fr, int fq) const {
        const int row0 = u.pm * BM + wr * 64 + fr; const int col0 = u.pn * BM + wc * 32 + 8 * fq;
        const bool first = u.pn < split_pn; const float* st = first ? st0 : st1; const int np = first ? np0 : np1; const float inv = first ? inv0 : inv1;
#pragma unroll
        for (int ai = 0; ai < 2; ++ai)
#pragma unroll
            for (int m = 0; m < 4; ++m) { const int row = row0 + ai * HALF + m * 16; float s = 0.f;
                for (int i = 0; i < np; i += 4) { const f32x4 p4 = *(const f32x4*)(st + (size_t)row * np + i); s += (p4[0] + p4[1]) + (p4[2] + p4[3]); }
                const float r = __builtin_amdgcn_rsqf(s * inv + eps);
                bf16_t* rowp = O + (size_t)row * ldc + col0;
#pragma unroll
                for (int bj = 0; bj < 2; ++bj) st_wt16(rowp + bj * HALF, pack8(acc[ai][bj][m][0] * r, acc[ai][bj][m][1] * r)); }
    }
};
struct EpiRes {
    static constexpr bool PERM = true, AFTER_DRAIN = false, KHOOK = false;
    bf16_t* XB; int ldc; float* stat; int Mrows;
    __device__ __forceinline__ void operator()(const f32x4 (&acc)[2][2][4][2], const Unit& u, int wr, int wc, int fr, int fq) const {
        int pm_ = u.pm, pn_ = u.pn; asm volatile("" : "+s"(pm_), "+s"(pn_));
        const int row0 = pm_ * BM + wr * 64 + fr; const int col0 = pn_ * BM + wc * 32 + 8 * fq;
        u32x4 b[2][4][2];
#pragma unroll
        for (int ai = 0; ai < 2; ++ai)
#pragma unroll
            for (int m = 0; m < 4; ++m)
#pragma unroll
                for (int bj = 0; bj < 2; ++bj) b[ai][m][bj] = *(const u32x4*)(XB + (size_t)(row0 + ai * HALF + m * 16) * ldc + col0 + bj * HALF);
#pragma unroll
        for (int ai = 0; ai < 2; ++ai)
#pragma unroll
            for (int m = 0; m < 4; ++m) { const int row = row0 + ai * HALF + m * 16; const size_t off = (size_t)row * ldc + col0; float s = 0.f;
#pragma unroll
                for (int bj = 0; bj < 2; ++bj) { const u32x4 bb = b[ai][m][bj];
                    f32x4 v0 = acc[ai][bj][m][0], v1 = acc[ai][bj][m][1];
                    v0[0] += __builtin_bit_cast(float, bb.x << 16); v0[1] += __builtin_bit_cast(float, bb.x & 0xffff0000u); v0[2] += __builtin_bit_cast(float, bb.y << 16); v0[3] += __builtin_bit_cast(float, bb.y & 0xffff0000u);
                    v1[0] += __builtin_bit_cast(float, bb.z << 16); v1[1] += __builtin_bit_cast(float, bb.z & 0xffff0000u); v1[2] += __builtin_bit_cast(float, bb.w << 16); v1[3] += __builtin_bit_cast(float, bb.w & 0xffff0000u);
                    *(u32x4*)(XB + off + bj * HALF) = pack8(v0, v1);
                    s += sumsq4(v0) + sumsq4(v1); }
                s += __shfl_xor(s, 16); s += __shfl_xor(s, 32);
                if (fq == 0) stat[(size_t)row * 16 + u.pn * 4 + wc] = s; }
    }
};
struct EpiResMix {
    static constexpr bool PERM = true, AFTER_DRAIN = false, KHOOK = true;
    bf16_t* XB; int ldc; float* stat; int Mrows; const PG8_LAS float* tbl;
    __device__ __forceinline__ void khook(f32x4 (&acc)[2][2][4][2], int t, int ui, int wr, int fr) const {
        if (t != 4 && t != 8) return;
        const int sel = (t == 8) ? 1 : 0;
#pragma unroll
        for (int ai = 0; ai < 2; ++ai)
#pragma unroll
            for (int m = 0; m < 4; ++m) { const float sc = tbl[(ui * 256 + ai * HALF + wr * 64 + m * 16 + fr) * 2 + sel];
#pragma unroll
                for (int bj = 0; bj < 2; ++bj)
#pragma unroll
                    for (int n = 0; n < 2; ++n) acc[ai][bj][m][n] *= sc; }
    }
    __device__ __forceinline__ void operator()(const f32x4 (&acc)[2][2][4][2], const Unit& u, int wr, int wc, int fr, int fq) const {
        const int row0 = u.pm * BM + wr * 64 + fr; const int col0 = u.pn * BM + wc * 32 + 8 * fq;
        u32x4 b[2][4][2];
#pragma unroll
        for (int ai = 0; ai < 2; ++ai)
#pragma unroll
            for (int m = 0; m < 4; ++m)
#pragma unroll
                for (int bj = 0; bj < 2; ++bj) b[ai][m][bj] = *(const u32x4*)(XB + (size_t)(row0 + ai * HALF + m * 16) * ldc + col0 + bj * HALF);
#pragma unroll
        for (int ai = 0; ai < 2; ++ai)
#pragma unroll
            for (int m = 0; m < 4; ++m) { const int row = row0 + ai * HALF + m * 16; const size_t off = (size_t)row * ldc + col0; float s = 0.f;
#pragma unroll
                for (int bj = 0; bj < 2; ++bj) { const u32x4 bb = b[ai][m][bj];
                    f32x4 v0 = acc[ai][bj][m][0], v1 = acc[ai][bj][m][1];
                    v0[0] += __builtin_bit_cast(float, bb.x << 16); v0[1] += __builtin_bit_cast(float, bb.x & 0xffff0000u); v0[2] += __builtin_bit_cast(float, bb.y << 16); v0[3] += __builtin_bit_cast(float, bb.y & 0xffff0000u);
                    v1[0] += __builtin_bit_cast(float, bb.z << 16); v1[1] += __builtin_bit_cast(float, bb.z & 0xffff0000u); v1[2] += __builtin_bit_cast(float, bb.w << 16); v1[3] += __builtin_bit_cast(float, bb.w & 0xffff0000u);
                    *(u32x4*)(XB + off + bj * HALF) = pack8(v0, v1);
                    s += sumsq4(v0) + sumsq4(v1); }
                s += __shfl_xor(s, 16); s += __shfl_xor(s, 32);
                if (fq == 0) stat[(size_t)row * 16 + u.pn * 4 + wc] = s; }
    }
};
struct EpiRouter {
    static constexpr bool PERM = false, AFTER_DRAIN = false, KHOOK = false;
    float* L; const float* st; float eps; int Mrows;
    __device__ __forceinline__ void operator()(const f32x4 (&acc)[2][2][4][2], const Unit& u, int wr, int wc, int fr, int fq) const {
        if (wc >= 2) return;
        const int row0 = u.pm * BM + wr * 64 + fr; const int col0 = wc * 32 + 4 * fq;
#pragma unroll
        for (int ai = 0; ai < 2; ++ai)
#pragma unroll
            for (int m = 0; m < 4; ++m) { const int row = row0 + ai * HALF + m * 16; float s = 0.f;
#pragma unroll
                for (int i = 0; i < 16; i += 4) { const f32x4 p4 = *(const f32x4*)(st + (size_t)row * 16 + i); s += (p4[0] + p4[1]) + (p4[2] + p4[3]); }
                const float r = __builtin_amdgcn_rsqf(s * (1.0f / 1024.0f) + eps);
#pragma unroll
                for (int n = 0; n < 2; ++n) *(f32x4*)(L + (size_t)row * 64 + col0 + 16 * n) = acc[ai][0][m][n] * r; }
    }
};
__device__ __forceinline__ float silu_mul(float g, float u) { return g * u * __builtin_amdgcn_rcpf(1.0f + __builtin_amdgcn_exp2f(-1.4426950408889634f * g)); }
struct EpiSwiglu {
    static constexpr bool PERM = true, AFTER_DRAIN = false, KHOOK = false;
    bf16_t* H; int ldc; const float* rs;
    __device__ __forceinline__ void operator()(const f32x4 (&acc)[2][2][4][2], const Unit& u, int wr, int wc, int fr, int fq) const {
        const int row0 = u.pm * BM + wr * 64 + fr; const int col0 = (u.pn & 1) * HALF + wc * 32 + 8 * fq;
#pragma unroll
        for (int ai = 0; ai < 2; ++ai)
#pragma unroll
            for (int m = 0; m < 4; ++m) { const int row = row0 + ai * HALF + m * 16; f32x4 h0, h1; const float r = rs[row];
#pragma unroll
                for (int j = 0; j < 4; ++j) { h0[j] = silu_mul(acc[ai][0][m][0][j] * r, acc[ai][1][m][0][j] * r); h1[j] = silu_mul(acc[ai][0][m][1][j] * r, acc[ai][1][m][1][j] * r); }
                *(u32x4*)(H + (size_t)row * ldc + col0) = pack8(h0, h1); }
    }
};
struct EpiSwigluWT {
    static constexpr bool PERM = true, AFTER_DRAIN = false, KHOOK = false;
    bf16_t* H; int ldc; const float* rs;
    __device__ __forceinline__ void operator()(const f32x4 (&acc)[2][2][4][2], const Unit& u, int wr, int wc, int fr, int fq) const {
        const int row0 = u.pm * BM + wr * 64 + fr; const int col0 = (u.pn & 1) * HALF + wc * 32 + 8 * fq;
#pragma unroll
        for (int ai = 0; ai < 2; ++ai)
#pragma unroll
            for (int m = 0; m < 4; ++m) { const int row = row0 + ai * HALF + m * 16; f32x4 h0, h1; const float r = rs[row];
#pragma unroll
                for (int j = 0; j < 4; ++j) { h0[j] = silu_mul(acc[ai][0][m][0][j] * r, acc[ai][1][m][0][j] * r); h1[j] = silu_mul(acc[ai][0][m][1][j] * r, acc[ai][1][m][1][j] * r); }
                const u32x4 hv = pack8(h0, h1); const bf16_t* hp = H + (size_t)row * ldc + col0; asm volatile("global_store_dwordx4 %0, %1, off sc1\n\ts_nop 2" :: "v"(hp), "v"(hv) : "memory"); }
    }
};
struct EpiDown {
    static constexpr bool PERM = true, AFTER_DRAIN = false, KHOOK = false;
    unsigned char* Y; int ldc; const float* w;
    __device__ __forceinline__ void operator()(const f32x4 (&acc)[2][2][4][2], const Unit& u, int wr, int wc, int fr, int fq) const {
        typedef unsigned u32x2 __attribute__((ext_vector_type(2)));
        const int row0 = u.pm * BM + wr * 64 + fr; const int col0 = (u.pn & 3) * BM + wc * 32 + 8 * fq;
#pragma unroll
        for (int ai = 0; ai < 2; ++ai)
#pragma unroll
            for (int m = 0; m < 4; ++m) { const int row = row0 + ai * HALF + m * 16; const float r = w[row];
                unsigned char* rowp = Y + (size_t)row * ldc + col0;
#pragma unroll
                for (int bj = 0; bj < 2; ++bj) { const f32x4 v0 = acc[ai][bj][m][0] * r, v1 = acc[ai][bj][m][1] * r;
                    int w0 = __builtin_amdgcn_cvt_pk_fp8_f32(v0[0], v0[1], 0, false); w0 = __builtin_amdgcn_cvt_pk_fp8_f32(v0[2], v0[3], w0, true);
                    int w1 = __builtin_amdgcn_cvt_pk_fp8_f32(v1[0], v1[1], 0, false); w1 = __builtin_amdgcn_cvt_pk_fp8_f32(v1[2], v1[3], w1, true);
                    *(u32x2*)(rowp + bj * HALF) = (u32x2){(unsigned)w0, (unsigned)w1}; } }
    }
};
struct EpiPlainBf16 {
    static constexpr bool PERM = true, AFTER_DRAIN = false, KHOOK = false;
    bf16_t* O; int ldc;
    __device__ __forceinline__ void operator()(const f32x4 (&acc)[2][2][4][2], const Unit& u, int wr, int wc, int fr, int fq) const {
        const int row0 = u.pm * BM + wr * 64 + fr; const int col0 = u.pn * BM + wc * 32 + 8 * fq;
#pragma unroll
        for (int ai = 0; ai < 2; ++ai)
#pragma unroll
            for (int m = 0; m < 4; ++m) { bf16_t* rowp = O + (size_t)(row0 + ai * HALF + m * 16) * ldc + col0;
#pragma unroll
                for (int bj = 0; bj < 2; ++bj) *(u32x4*)(rowp + bj * HALF) = pack8(acc[ai][bj][m][0], acc[ai][bj][m][1]); }
    }
};
struct MoeOrder {
    const int* blk_expert; int nunits, G, c, sh;
    __device__ __forceinline__ bool next(int i, Unit& u) const {
        const int L = i * G + c; if (L >= nunits) return false;
        u.pm = __builtin_amdgcn_readfirstlane(L >> sh); u.pn = __builtin_amdgcn_readfirstlane((blk_expert[u.pm] << sh) + (L & ((1 << sh) - 1))); return true;
    }
    __device__ __forceinline__ void a_ready(const Unit&) const {}
    __device__ __forceinline__ void done(const Unit&) const {}
};

struct MoeTailOrder {
    const int* blk_expert; int L0, mainblk; unsigned* flg; int lane;
    __device__ __forceinline__ bool next(int i, Unit& u) const { if (i != 0) return false;
        u.pm = __builtin_amdgcn_readfirstlane(L0 >> 1); u.pn = __builtin_amdgcn_readfirstlane((blk_expert[u.pm] << 1) + (L0 & 1)); return true; }
    __device__ __forceinline__ void a_ready(const Unit&) const {}
    __device__ __forceinline__ void done(const Unit& u) const {
        asm volatile("s_waitcnt vmcnt(0)" ::: "memory");
        if (lane == 0) (void)__hip_atomic_fetch_add(&flg[64 * (u.pm - mainblk)], 1u, __ATOMIC_RELAXED, __HIP_MEMORY_SCOPE_AGENT);
    }
};
struct MoeOrderY {
    const int* blk_expert; int nunits, G, c, T, SKIP, mainblk, RG; unsigned* flg; int lane;
    __device__ __forceinline__ bool next(int i, Unit& u) const {
        int L;
        if (c >= T) L = (i < SKIP) ? i * (G - T) + (c - T) : SKIP * (G - T) + (i - SKIP) * G + c;
        else L = SKIP * (G - T) + i * G + c;
        if (L >= nunits) return false;
        u.pm = __builtin_amdgcn_readfirstlane(L >> 2); u.pn = __builtin_amdgcn_readfirstlane((blk_expert[u.pm] << 2) + (L & 3)); return true;
    }
    __device__ __forceinline__ void a_ready(const Unit& u) const {
        if (u.pm >= mainblk) {
            const unsigned need = 8u * (unsigned)((2 * u.pm >= RG ? 1 : 0) + (2 * u.pm + 1 >= RG ? 1 : 0));
            if (lane == 0) { unsigned sp = 0u; while (__hip_atomic_load(&flg[64 * (u.pm - mainblk)], __ATOMIC_RELAXED, __HIP_MEMORY_SCOPE_AGENT) < need) { __builtin_amdgcn_s_sleep(2); if (++sp > (1u << 22)) break; } }
            __builtin_amdgcn_fence(__ATOMIC_ACQUIRE, "agent");
        }
    }
    __device__ __forceinline__ void done(const Unit&) const {}
};

template <class Epi, class Sched, bool ALIGN_EPI = false, bool SP2 = false, bool GATHER = false>
__device__ __forceinline__ void gemm_phase(PG8_LAS unsigned char* lds, const Gemm g, const Sched& S, const Epi& E, const PG8_LAS int* gidx = nullptr) {
    const int tid = tid_now(), wid = __builtin_amdgcn_readfirstlane(tid >> 6), lane = tid & 63, wr = wid >> 2, wc = wid & 3, fr = lane & 15, fq = lane >> 4;
    const int K = g.K, nt = K / BK; const int lda = g.lda, ldb = g.ldb;
    unsigned voffA[2], voffB[2]; int Rg[2], Cg[2]; unsigned gA[2][2], gN[2][2];
#pragma unroll
    for (int i = 0; i < 2; ++i) { int R, C; stage_rc(tid * 16 + i * 8192, R, C); const int Rb = Epi::PERM ? ((R & ~31) + perm32(R & 31)) : R;
        voffA[i] = (unsigned)(R * lda + C) * 2u; voffB[i] = (unsigned)(Rb * ldb + C) * 2u; Rg[i] = R; Cg[i] = C; }
    const size_t kstep = (size_t)(BK * 2);
    const size_t hstepA = (size_t)HALF * lda * 2, hstepB = (size_t)HALF * ldb * 2;
    const size_t tstepA = 2 * hstepA, tstepB = 2 * hstepB;
    const unsigned ldsw = (unsigned)wid * 1024u;
    const int aoff = lds_byte(wr * 64 + fr, fq * 8), boff = lds_byte(wc * 32 + fr, fq * 8);
#define PG8_SA(b, h) (((b) * 2 + (h)) * HTB)
#define PG8_SB(b, h) ((4 + (b) * 2 + (h)) * HTB)
#define PG8_STAGE(bufoff, gbase, voff) do { _Pragma("unroll") for (int _i = 0; _i < 2; ++_i) \
        __builtin_amdgcn_global_load_lds((const unsigned*)((const char*)(gbase) + (voff)[_i]), (PG8_LAS unsigned*)(lds + (bufoff) + ldsw + _i * 8192), 16, 0, 0); } while (0)
#define PG8_GOFF(dst, ui_) do { _Pragma("unroll") for (int _h = 0; _h < 2; ++_h) _Pragma("unroll") for (int _i = 0; _i < 2; ++_i) dst[_h][_i] = ((unsigned)gidx[(ui_) * 256 + _h * HALF + Rg[_i]] * (unsigned)lda + (unsigned)Cg[_i]) * 2u; } while (0)
#define PG8_STAGE_A(bufoff, gbase, H, USE_NEXT) do { if constexpr (GATHER) { _Pragma("unroll") for (int _i = 0; _i < 2; ++_i) { const unsigned _o = (USE_NEXT) ? gN[H][_i] : gA[H][_i]; \
        __builtin_amdgcn_global_load_lds((const unsigned*)((const char*)(gbase) + _o), (PG8_LAS unsigned*)(lds + (bufoff) + ldsw + _i * 8192), 16, 0, 0); } } \
    else { PG8_STAGE(bufoff, (gbase) + ((H) ? hstepA : 0), voffA); } } while (0)
#define PG8_LDA(dst, b, h) do { _Pragma("unroll") for (int m = 0; m < 4; ++m) _Pragma("unroll") for (int k = 0; k < 2; ++k) dst[m][k] = *(const PG8_LAS bf16x8*)(lds + PG8_SA(b, h) + aoff + m * 2048 + k * 1024); } while (0)
#define PG8_LDB(dst, b, h) do { _Pragma("unroll") for (int n = 0; n < 2; ++n) _Pragma("unroll") for (int k = 0; k < 2; ++k) dst[n][k] = *(const PG8_LAS bf16x8*)(lds + PG8_SB(b, h) + boff + n * 2048 + k * 1024); } while (0)
#define PG8_MMA(ai, bj, At, Bt) do { __builtin_amdgcn_s_setprio(1); _Pragma("unroll") for (int m = 0; m < 4; ++m) _Pragma("unroll") for (int n = 0; n < 2; ++n) _Pragma("unroll") for (int k = 0; k < 2; ++k) \
        acc[ai][bj][m][n] = __builtin_amdgcn_mfma_f32_16x16x32_bf16(Bt[n][k], At[m][k], acc[ai][bj][m][n], 0, 0, 0); __builtin_amdgcn_s_setprio(0); } while (0)
#define PG8_WAIT_V(n) asm volatile("s_waitcnt vmcnt(" #n ")" ::: "memory")
#define PG8_WAIT_L(n) asm volatile("s_waitcnt lgkmcnt(" #n ")" ::: "memory")
#define PG8_BAR __builtin_amdgcn_s_barrier()
#define PG8_SCHED __builtin_amdgcn_sched_barrier(0)
    Unit cur, nxt; int ui = 0;
    if (!S.next(0, cur)) return;
    f32x4 acc[2][2][4][2];
#pragma unroll
    for (int a = 0; a < 2; ++a)
#pragma unroll
        for (int b = 0; b < 2; ++b)
#pragma unroll
            for (int m = 0; m < 4; ++m)
#pragma unroll
                for (int n = 0; n < 2; ++n) acc[a][b][m][n] = (f32x4){0.f, 0.f, 0.f, 0.f};
    bf16x8 At[4][2], B0[2][2], B1[2][2];
    const char* cA = (const char*)g.A + (GATHER ? (size_t)0 : (size_t)cur.pm * tstepA); if constexpr (GATHER) { PG8_GOFF(gA, 0); }
    const char* cB = (const char*)g.Bt + (size_t)cur.pn * tstepB;
    S.a_ready(cur);
    if constexpr (SP2) {
        PG8_STAGE(PG8_SB(0, 0), cB, voffB); PG8_STAGE(PG8_SB(0, 1), cB + hstepB, voffB); PG8_STAGE_A(PG8_SA(0, 0), cA, 0, false); PG8_STAGE_A(PG8_SA(0, 1), cA, 1, false);
        if (wr == 1) PG8_BAR;
        PG8_WAIT_V(2); PG8_BAR;
        PG8_STAGE(PG8_SB(1, 0), cB + kstep, voffB); PG8_STAGE_A(PG8_SA(1, 0), cA + kstep, 0, false); PG8_STAGE(PG8_SB(1, 1), cB + hstepB + kstep, voffB);
        PG8_WAIT_V(6); PG8_BAR;
    } else {
        PG8_STAGE(PG8_SB(0, 0), cB, voffB); PG8_STAGE_A(PG8_SA(0, 0), cA, 0, false); PG8_STAGE(PG8_SB(0, 1), cB + hstepB, voffB); PG8_STAGE_A(PG8_SA(0, 1), cA, 1, false);
        if (wr == 1) PG8_BAR;
        PG8_WAIT_V(4); PG8_BAR;
        PG8_STAGE(PG8_SB(1, 0), cB + kstep, voffB); PG8_STAGE_A(PG8_SA(1, 0), cA + kstep, 0, false); PG8_STAGE(PG8_SB(1, 1), cB + hstepB + kstep, voffB);
        PG8_WAIT_V(6); PG8_BAR;
    }
    for (;;) {
        const bool has_next = S.next(ui + 1, nxt);
        const char* nA = (has_next && !GATHER) ? (const char*)g.A + (size_t)nxt.pm * tstepA : cA;
        if constexpr (GATHER) { if (has_next) { PG8_GOFF(gN, ui + 1); } else { _Pragma("unroll") for (int _h = 0; _h < 2; ++_h) _Pragma("unroll") for (int _i = 0; _i < 2; ++_i) gN[_h][_i] = gA[_h][_i]; } }
        const char* nB = has_next ? (const char*)g.Bt + (size_t)nxt.pn * tstepB : cB;
#pragma unroll 1
        for (int t = 0; t < nt; t += 2) {
            if constexpr (Epi::KHOOK) E.khook(acc, t, ui, wr, fr);
            const bool last = (t == nt - 2);
            const char* a1 = cA + (size_t)(t + 1) * kstep;
            const char* a2 = last ? nA : cA + (size_t)(t + 2) * kstep; const char* b2 = last ? nB : cB + (size_t)(t + 2) * kstep;
            const char* a3 = a2 + kstep; const char* b3 = b2 + kstep;
            if (last && has_next) S.a_ready(nxt);
            if constexpr (SP2) {
            PG8_LDB(B0, 0, 0); PG8_LDB(B1, 0, 1); PG8_SCHED; PG8_LDA(At, 0, 0); PG8_STAGE_A(PG8_SA(1, 1), a1, 1, false);
            PG8_WAIT_V(8); PG8_WAIT_L(0); PG8_BAR; PG8_MMA(0, 0, At, B0); PG8_MMA(0, 1, At, B1); PG8_BAR; PG8_SCHED;
            PG8_LDA(At, 0, 1); PG8_STAGE(PG8_SB(0, 0), b2, voffB); PG8_STAGE(PG8_SB(0, 1), b2 + hstepB, voffB); PG8_STAGE_A(PG8_SA(0, 0), a2, 0, last);
            PG8_WAIT_V(8); PG8_WAIT_L(0); PG8_BAR; PG8_MMA(1, 0, At, B0); PG8_MMA(1, 1, At, B1); PG8_BAR; PG8_SCHED;
            PG8_LDB(B0, 1, 0); PG8_LDB(B1, 1, 1); PG8_SCHED; PG8_LDA(At, 1, 0); PG8_STAGE_A(PG8_SA(0, 1), a2, 1, last);
            PG8_WAIT_V(8); PG8_WAIT_L(0); PG8_BAR; PG8_MMA(0, 0, At, B0); PG8_MMA(0, 1, At, B1); PG8_BAR; PG8_SCHED;
            PG8_LDA(At, 1, 1); PG8_STAGE(PG8_SB(1, 0), b3, voffB); PG8_STAGE(PG8_SB(1, 1), b3 + hstepB, voffB); PG8_STAGE_A(PG8_SA(1, 0), a3, 0, last);
            PG8_WAIT_V(8); PG8_WAIT_L(0); PG8_BAR; PG8_MMA(1, 0, At, B0); PG8_MMA(1, 1, At, B1); PG8_BAR; PG8_SCHED;
            } else {
            PG8_LDB(B0, 0, 0); PG8_SCHED; PG8_LDA(At, 0, 0); PG8_STAGE_A(PG8_SA(1, 1), a1, 1, false);
            PG8_WAIT_L(8); PG8_BAR; PG8_WAIT_L(0); PG8_MMA(0, 0, At, B0); PG8_BAR; PG8_SCHED;
            PG8_LDB(B1, 0, 1); PG8_STAGE(PG8_SB(0, 0), b2, voffB);
            PG8_BAR; PG8_WAIT_L(0); PG8_MMA(0, 1, At, B1); PG8_BAR;
            PG8_LDA(At, 0, 1); PG8_STAGE_A(PG8_SA(0, 0), a2, 0, last);
            PG8_BAR; PG8_WAIT_L(0); PG8_MMA(1, 0, At, B0); PG8_BAR; PG8_SCHED;
            PG8_STAGE(PG8_SB(0, 1), b2 + hstepB, voffB);
            PG8_WAIT_V(6); PG8_BAR; PG8_MMA(1, 1, At, B1); PG8_BAR;
            PG8_LDB(B0, 1, 0); PG8_SCHED; PG8_LDA(At, 1, 0); PG8_STAGE_A(PG8_SA(0, 1), a2, 1, last);
            PG8_WAIT_L(8); PG8_BAR; PG8_WAIT_L(0); PG8_MMA(0, 0, At, B0); PG8_BAR; PG8_SCHED;
            PG8_LDB(B1, 1, 1); PG8_STAGE(PG8_SB(1, 0), b3, voffB);
            PG8_BAR; PG8_WAIT_L(0); PG8_MMA(0, 1, At, B1); PG8_BAR;
            PG8_LDA(At, 1, 1); PG8_STAGE_A(PG8_SA(1, 0), a3, 0, last);
            PG8_BAR; PG8_WAIT_L(0); PG8_MMA(1, 0, At, B0); PG8_BAR; PG8_SCHED;
            PG8_STAGE(PG8_SB(1, 1), b3 + hstepB, voffB);
            PG8_WAIT_V(6); PG8_BAR; PG8_MMA(1, 1, At, B1); PG8_BAR;
            }
        }
        if constexpr (ALIGN_EPI) { if (wr == 0) PG8_BAR; }
        if constexpr (!Epi::AFTER_DRAIN) { E(acc, cur, wr, wc, fr, fq); S.done(cur); }
        if (!has_next) break;
#pragma unroll
        for (int a = 0; a < 2; ++a)
#pragma unroll
            for (int b = 0; b < 2; ++b)
#pragma unroll
                for (int m = 0; m < 4; ++m)
#pragma unroll
                    for (int n = 0; n < 2; ++n) acc[a][b][m][n] = (f32x4){0.f, 0.f, 0.f, 0.f};
        cur = nxt; cA = nA; cB = nB; ++ui;
        if constexpr (GATHER) { _Pragma("unroll") for (int _h = 0; _h < 2; ++_h) _Pragma("unroll") for (int _i = 0; _i < 2; ++_i) gA[_h][_i] = gN[_h][_i]; }
        if constexpr (ALIGN_EPI) { if (wr == 1) PG8_BAR; }
    }
    PG8_WAIT_V(0);
    if constexpr (!ALIGN_EPI) { if (wr == 0) PG8_BAR; }
    PG8_BAR;
    if constexpr (Epi::AFTER_DRAIN) { E.fused(acc, cur, wr, wc, fr, fq, lds, wid, lane); S.done(cur); }
#undef PG8_SA
#undef PG8_SB
#undef PG8_STAGE
#undef PG8_GOFF
#undef PG8_STAGE_A
#undef PG8_LDA
#undef PG8_LDB
#undef PG8_MMA
#undef PG8_WAIT_V
#undef PG8_WAIT_L
#undef PG8_BAR
#undef PG8_SCHED
}
}

#ifndef PG8_SP2
#define PG8_SP2 true
#endif
#ifndef PG8_ALIGN
#define PG8_ALIGN true
#endif

constexpr int NB = 8, SEQ = 4096, D = 1024, M = NB * SEQ;
constexpr int NL = 2;
constexpr int MEMLEN = 256, MM = NB * MEMLEN;
constexpr int UW = 2048;
constexpr int INC = 1952;
constexpr int NEXP = 32, DEXP = 256;
constexpr int PSLOTS = 73728;
constexpr int NBLK_MAX = PSLOTS / 256;
constexpr float EPS = 1e-6f;
constexpr float LOG2E = 1.4426950408889634f;
constexpr int NWAVES = 8, NTHR = 512;

constexpr int UC_CQ = 0, UC_CKV = 256, UC_ROPE = 384, UC_POOL = 512, UC_SQ = 768, UC_SK = 1024, UC_SV = 1152, UC_CB = 1280, UC_CC = 1536, UC_CH = 1792;
constexpr int QC_KR = 384, QC_KV = 512;

constexpr size_t MiB = 1u << 20;
constexpr size_t WS_CTL = 0, CTL_ZERO_BYTES = 1 * MiB;
constexpr size_t WL_IN = 0, WL_UP = WL_IN + (size_t)UW * D * 2, WL_MIX = WL_UP + (size_t)1024 * 384 * 2, WL_XQ = WL_MIX + (size_t)D * D * 2, WL_XO = WL_XQ + (size_t)256 * D * 2,
                 WL_R = WL_XO + (size_t)D * 256 * 2, WL_GU = WL_R + (size_t)256 * D * 2, WL_DN = WL_GU + (size_t)NEXP * 512 * D * 2, WL_END = WL_DN + (size_t)NEXP * D * 256 * 2;
static_assert(WL_END <= 57 * MiB, "per-layer weights");
constexpr size_t WS_W = 1 * MiB;
constexpr size_t WS_XKV = WS_W + 2 * 57 * MiB;
constexpr size_t WS_MN = WS_XKV + 2 * MiB;
constexpr size_t WS_KVX = WS_MN + 4 * MiB;
constexpr size_t WS_STQ = WS_KVX + 4 * MiB;
constexpr size_t WS_STKV = WS_STQ + (size_t)4 * M * 4;
constexpr size_t WS_STX = WS_STKV + (size_t)4 * M * 4;
constexpr size_t WS_LOG = WS_STX + (size_t)16 * M * 4;
constexpr size_t WS_EID = WS_LOG + (size_t)M * 64 * 4;
constexpr size_t WS_WT = WS_EID + (size_t)M * 2 * 4;
constexpr size_t WS_SLOT = WS_WT + (size_t)M * 2 * 4;
constexpr size_t WS_WSLOT = WS_SLOT + (size_t)M * 2 * 4;
constexpr size_t WS_HIST = WS_WSLOT + (size_t)PSLOTS * 4;
constexpr size_t WS_BLKE = WS_HIST + (size_t)256 * 32 * 4;
constexpr size_t WS_TOK = WS_BLKE + 4096;
constexpr size_t WS_RSLOT = WS_TOK + (size_t)PSLOTS * 4;
constexpr size_t WS_XB = 144 * MiB;
static_assert(WS_RSLOT + (size_t)PSLOTS * 4 <= WS_XB && (NBLK_MAX + 16) * 4 <= 4096, "small buffers");
constexpr size_t WS_R1 = WS_XB + 64 * MiB;
constexpr size_t WS_U = WS_R1, WS_QKV = WS_R1 + 128 * MiB, WS_XG = WS_R1, WS_YB = WS_R1;
constexpr size_t WS_Y = WS_R1 + 192 * MiB;
constexpr size_t WS_H = WS_Y;
constexpr size_t WS_QX = WS_Y + 64 * MiB;
constexpr size_t WS_OX = WS_QX + 16 * MiB;
constexpr size_t WS_END0 = WS_OX + 16 * MiB;
constexpr int ECAP = 32768;
constexpr size_t WS_TOKR = WS_END0;
constexpr size_t WS_RSR = WS_TOKR + (size_t)NEXP * ECAP * 4;
constexpr size_t WS_WR = WS_RSR + (size_t)NEXP * ECAP * 4;
constexpr size_t WS_END = WS_WR + (size_t)NEXP * ECAP * 4;
static_assert(WS_END <= 512 * MiB, "workspace");
constexpr int CW_BAR = 4096;
constexpr int CW_FQ = 81920, CW_FO = 98304;
constexpr int CW_FLG = 16384;
constexpr int CW_CNT = 8192;

constexpr int RING_OFF = 0, RING_BYTES = 131072;
constexpr int LDSCTL_OFF = 143360, MISC_OFF = LDSCTL_OFF + 320;
constexpr int LDS_BYTES = 147456;

#define GAS __attribute__((address_space(1)))
#define LAS __attribute__((address_space(3)))
typedef unsigned short bf16;
typedef unsigned v4u __attribute__((ext_vector_type(4)));
typedef unsigned v2u __attribute__((ext_vector_type(2)));
typedef float f32x4 __attribute__((ext_vector_type(4)));
typedef float f32x16 __attribute__((ext_vector_type(16)));
typedef short bf16x8 __attribute__((ext_vector_type(8)));
typedef short s16x4 __attribute__((ext_vector_type(4)));
typedef GAS unsigned gu32;
#define RLX_AGENT __ATOMIC_RELAXED, __HIP_MEMORY_SCOPE_AGENT
#define LDS_WAIT() asm volatile("s_waitcnt lgkmcnt(0)" ::: "memory")
#define VM_WAIT() asm volatile("s_waitcnt vmcnt(0)" ::: "memory")
__device__ __forceinline__ unsigned f2bf(float f) { unsigned u = __builtin_bit_cast(unsigned, f); return (u + 0x7fffu + ((u >> 16) & 1u)) >> 16; }
__device__ __forceinline__ unsigned pk2(float lo, float hi) { return f2bf(lo) | (f2bf(hi) << 16); }
__device__ __forceinline__ float bf2f(unsigned h) { return __builtin_bit_cast(float, h << 16); }
__device__ __forceinline__ float bflo(unsigned w) { return __builtin_bit_cast(float, w << 16); }
__device__ __forceinline__ float bfhi(unsigned w) { return __builtin_bit_cast(float, w & 0xffff0000u); }
__device__ __forceinline__ float wave_sum(float v) {
#pragma unroll
    for (int o = 1; o < 64; o <<= 1) v += __shfl_xor(v, o);
    return v;
}
__device__ __forceinline__ float sum16(float v) { v += __shfl_xor(v, 1); v += __shfl_xor(v, 2); v += __shfl_xor(v, 4); v += __shfl_xor(v, 8); return v; }
__device__ __forceinline__ float sum32(float v) { v = sum16(v); v += __shfl_xor(v, 16); return v; }

#define XB_TMO      128
#define XB_XCNT(j)  (256  + 64 * (j))
#define XB_XSUB(j)  (1280 + 64 * (j))
#define XB_XGEN(j)  (2304 + 64 * (j))
#define XB_TOP      3328
#define XB_TOPGEN   3392
#define XCD_BAR_WORDS 3456
#define XB_SPIN_CAP (1u << 18)
__device__ __forceinline__ unsigned xb_ld(unsigned* p)              { return __hip_atomic_load(p, __ATOMIC_RELAXED, __HIP_MEMORY_SCOPE_AGENT); }
__device__ __forceinline__ unsigned xb_add(unsigned* p, unsigned v) { return __hip_atomic_fetch_add(p, v, __ATOMIC_RELAXED, __HIP_MEMORY_SCOPE_AGENT); }
__device__ __forceinline__ unsigned xb_xcc_id() { return (unsigned)__builtin_amdgcn_s_getreg((3 << 11) | 20) & 0xFu; }
#define XB_SPIN(cond, bar) do { unsigned _sp = 0; while (cond) { __builtin_amdgcn_s_sleep(1); \
    if ((++_sp & 255u) == 0u) { if (xb_ld(&(bar)[XB_TMO])) break; if (_sp > XB_SPIN_CAP) { atomicAdd(&(bar)[XB_TMO], 1u); break; } } } } while (0)
struct XcdBarrier { unsigned* bar; unsigned x; volatile LAS unsigned* st; };
__device__ __forceinline__ XcdBarrier xcd_barrier_post(unsigned* bar, volatile LAS unsigned* st) {
    XcdBarrier b; b.bar = bar; b.x = xb_xcc_id(); b.st = st;
    if (threadIdx.x == 0) (void)xb_add(&bar[XB_XCNT(b.x)], 1u);
    return b;
}
__device__ __forceinline__ void xcd_barrier_complete(unsigned* bar, unsigned x, unsigned& nloc, unsigned& nx) {
    const unsigned G = (unsigned)kernarg_G();
    unsigned sum, cnt, mine, sp = 0u;
    for (;;) {
        sum = 0u; cnt = 0u; mine = 0u;
#pragma unroll
        for (unsigned j = 0; j < 16; ++j) { const unsigned c = xb_ld(&bar[XB_XCNT(j)]); sum += c; cnt += (c > 0u) ? 1u : 0u; mine = (j == x) ? c : mine; }
        if (sum == G) break;
        __builtin_amdgcn_s_sleep(1);
        if ((++sp & 255u) == 0u) { if (xb_ld(&bar[XB_TMO])) break; if (sp > XB_SPIN_CAP) { atomicAdd(&bar[XB_TMO], 1u); break; } }
    }
    nloc = mine > 0u ? mine : 1u; nx = cnt > 0u ? cnt : 1u;
}
__device__ __forceinline__ void xcd_barrier(const XcdBarrier& b) {
    asm volatile("s_waitcnt vmcnt(0)" ::: "memory");
    __syncthreads();
    if (threadIdx.x == 0) {
        unsigned* bar = b.bar;
        __builtin_amdgcn_s_waitcnt(0);
        unsigned nloc = b.st[0], nx = b.st[1];
        if (nloc == 0u) { xcd_barrier_complete(bar, b.x, nloc, nx); b.st[0] = nloc; b.st[1] = nx; }
        const unsigned old = xb_add(&bar[XB_XSUB(b.x)], 1u);
        const unsigned gen = old / nloc;
        if (old + 1u == (gen + 1u) * nloc) {
            __builtin_amdgcn_fence(__ATOMIC_RELEASE, "agent");
            asm volatile("s_waitcnt vmcnt(0)" ::: "memory");
            const unsigned og = xb_add(&bar[XB_TOP], 1u);
            const unsigned tg = og / nx;
            if (og + 1u == (tg + 1u) * nx) xb_add(&bar[XB_TOPGEN], 1u);
            else XB_SPIN(xb_ld(&bar[XB_TOPGEN]) == tg, bar);
            __builtin_amdgcn_fence(__ATOMIC_ACQUIRE, "agent");
            xb_add(&bar[XB_XGEN(b.x)], 1u);
            asm volatile("s_waitcnt vmcnt(0)" ::: "memory");
        } else {
            XB_SPIN(xb_ld(&bar[XB_XGEN(b.x)]) == gen, bar);
            __builtin_amdgcn_fence(__ATOMIC_ACQUIRE, "agent");
            asm volatile("s_waitcnt vmcnt(0)" ::: "memory");
        }
    }
    __syncthreads();
}

struct Frame {
    LAS unsigned char* lds; volatile LAS unsigned* MISC;
    int tid, lane, wave, vcu, G, gw, NGW, bx;
    unsigned char* ws; float* X;
};

__device__ __forceinline__ void tr_item(const float* src, int ldw, const float* gain, bf16* dst, int ldt, LAS float* scr, int lane) {
    f32x4 v[8]; float gv[8];
#pragma unroll
    for (int i = 0; i < 8; ++i) { const int kk = (lane >> 3) + 8 * i; v[i] = *(const GAS f32x4*)(src + (size_t)kk * ldw + 4 * (lane & 7)); gv[i] = gain ? gain[kk] : 1.0f; }
#pragma unroll
    for (int i = 0; i < 8; ++i) { const int kk = (lane >> 3) + 8 * i; LAS float* p = scr + kk * 33 + 4 * (lane & 7); p[0] = v[i].x * gv[i]; p[1] = v[i].y * gv[i]; p[2] = v[i].z * gv[i]; p[3] = v[i].w * gv[i]; }
    LDS_WAIT(); asm volatile("" ::: "memory");
    const int c = lane & 7;
#pragma unroll
    for (int j = 0; j < 4; ++j) { const int n = (lane >> 3) + 8 * j; const LAS float* sp = scr + (8 * c) * 33 + n;
        v4u o; o.x = pk2(sp[0 * 33], sp[1 * 33]); o.y = pk2(sp[2 * 33], sp[3 * 33]); o.z = pk2(sp[4 * 33], sp[5 * 33]); o.w = pk2(sp[6 * 33], sp[7 * 33]);
        *(GAS v4u*)(dst + (size_t)n * ldt + 8 * c) = o; }
    LDS_WAIT(); asm volatile("" ::: "memory");
}
constexpr int IT_IN = 16 * 53, IT_POOL = 128 * 8, IT_ZIN = 96, IT_UQ = 4 * 12, IT_UKV = 2 * 16, IT_ZUP = 1024, IT_MIX = 16 * 32, IT_XQ = 16 * 8, IT_XKV = 16 * 16, IT_XO = 4 * 32,
              IT_RE = 16, IT_RG = 16, IT_GU = NEXP * 256, IT_DN = NEXP * 128;
constexpr int IT_O_POOL = IT_GU + IT_DN + IT_IN, IT_O_XKV = IT_O_POOL + IT_POOL + IT_ZIN + IT_UQ + IT_UKV + IT_ZUP + IT_MIX + IT_XQ;
constexpr int IT_LAYER = IT_IN + IT_POOL + IT_ZIN + IT_UQ + IT_UKV + IT_ZUP + IT_MIX + IT_XQ + IT_XKV + IT_XO + IT_RE + IT_RG + IT_GU + IT_DN;

template <int NI> __device__ __forceinline__ void tr_items(const float* const (&src)[NI], int ldw, const float* const (&gain)[NI], bf16* const (&dst)[NI], int ldt, LAS float* scr, int lane) {
    f32x4 v[NI][8]; float gv[NI][8];
#pragma unroll
    for (int q = 0; q < NI; ++q)
#pragma unroll
        for (int i = 0; i < 8; ++i) { const int kk = (lane >> 3) + 8 * i; v[q][i] = *(const GAS f32x4*)(src[q] + (size_t)kk * ldw + 4 * (lane & 7)); gv[q][i] = gain[q] ? gain[q][kk] : 1.0f; }
#pragma unroll
    for (int q = 0; q < NI; ++q)
#pragma unroll
        for (int i = 0; i < 8; ++i) { const int kk = (lane >> 3) + 8 * i; LAS float* p = scr + q * 2112 + kk * 33 + 4 * (lane & 7); p[0] = v[q][i].x * gv[q][i]; p[1] = v[q][i].y * gv[q][i]; p[2] = v[q][i].z * gv[q][i]; p[3] = v[q][i].w * gv[q][i]; }
    LDS_WAIT(); asm volatile("" ::: "memory");
    const int c = lane & 7;
#pragma unroll
    for (int q = 0; q < NI; ++q)
#pragma unroll
        for (int j = 0; j < 4; ++j) { const int n = (lane >> 3) + 8 * j; const LAS float* sp = scr + q * 2112 + (8 * c) * 33 + n;
            v4u o; o.x = pk2(sp[0 * 33], sp[1 * 33]); o.y = pk2(sp[2 * 33], sp[3 * 33]); o.z = pk2(sp[4 * 33], sp[5 * 33]); o.w = pk2(sp[6 * 33], sp[7 * 33]);
            *(GAS v4u*)(dst[q] + (size_t)n * ldt + 8 * c) = o; }
    LDS_WAIT(); asm volatile("" ::: "memory");
}
template <int NI> __device__ __forceinline__ void tr_items16(const float* const (&src)[NI], int ldw, const float* const (&gain)[NI], bf16* const (&dst)[NI], int ldt, LAS unsigned short* scr, int lane) {
    f32x4 v[NI][8]; float gv[NI][8];
#pragma unroll
    for (int q = 0; q < NI; ++q)
#pragma unroll
        for (int i = 0; i < 8; ++i) { const int kk = (lane >> 3) + 8 * i; v[q][i] = *(const GAS f32x4*)(src[q] + (size_t)kk * ldw + 4 * (lane & 7)); gv[q][i] = gain[q] ? gain[q][kk] : 1.0f; }
#pragma unroll
    for (int q = 0; q < NI; ++q)
#pragma unroll
        for (int i = 0; i < 8; ++i) { const int kk = (lane >> 3) + 8 * i; LAS unsigned short* p = scr + q * 2176 + kk * 34 + 4 * (lane & 7);
            p[0] = (unsigned short)f2bf(v[q][i].x * gv[q][i]); p[1] = (unsigned short)f2bf(v[q][i].y * gv[q][i]); p[2] = (unsigned short)f2bf(v[q][i].z * gv[q][i]); p[3] = (unsigned short)f2bf(v[q][i].w * gv[q][i]); }
    LDS_WAIT(); asm volatile("" ::: "memory");
    const int c = lane & 7;
#pragma unroll
    for (int q = 0; q < NI; ++q)
#pragma unroll
        for (int j = 0; j < 4; ++j) { const int n = (lane >> 3) + 8 * j; const LAS unsigned short* sp = scr + q * 2176 + (8 * c) * 34 + n;
            v4u o; o.x = (unsigned)sp[0 * 34] | ((unsigned)sp[1 * 34] << 16); o.y = (unsigned)sp[2 * 34] | ((unsigned)sp[3 * 34] << 16); o.z = (unsigned)sp[4 * 34] | ((unsigned)sp[5 * 34] << 16); o.w = (unsigned)sp[6 * 34] | ((unsigned)sp[7 * 34] << 16);
            *(GAS v4u*)(dst[q] + (size_t)n * ldt + 8 * c) = o; }
    LDS_WAIT(); asm volatile("" ::: "memory");
}
template <int WHICH> __device__ __forceinline__ void expert_item(const Frame& F, int l, int r, const float*& src, const float*& gain, bf16*& dst) {
    unsigned char* wl = F.ws + WS_W + (size_t)l * 57 * MiB;
    if (WHICH == 0) { const int e = r >> 8, q = r & 255, which = q >> 7, q2 = q & 127, kb = q2 >> 3, nb = q2 & 7, n0 = 32 * nb;
        const float* W = (which ? (const float*)ARGP(33) : (const float*)ARGP(32)) + ((size_t)l * NEXP + e) * D * DEXP;
        src = W + (size_t)(64 * kb) * DEXP + n0; gain = (const float*)ARGP(27) + (size_t)l * D + 64 * kb;
        dst = (bf16*)(wl + WL_GU) + ((size_t)e * 512 + 256 * (n0 >> 7) + 128 * which + (n0 & 127)) * D + 64 * kb; }
    else { const int e = r >> 7, q = r & 127, kb = q >> 5, nb = q & 31;
        const float* W = (const float*)ARGP(34) + ((size_t)l * NEXP + e) * DEXP * D;
        src = W + (size_t)(64 * kb) * D + 32 * nb; gain = nullptr; dst = (bf16*)(wl + WL_DN) + ((size_t)e * D + 32 * nb) * DEXP + 64 * kb; }
}
template <int WHICH> __device__ __forceinline__ void prep_experts(const Frame& F, int l, int w0, int nw) {
    LAS float* scr = (LAS float*)(F.lds + RING_OFF + F.wave * 17408);
    constexpr int NIT = WHICH == 0 ? IT_GU : IT_DN, ldw = WHICH == 0 ? DEXP : D, ldt = WHICH == 0 ? D : DEXP;
    int it = w0;
    for (; it + 3 * nw < NIT; it += 4 * nw) { const float* src[4]; const float* gain[4]; bf16* dst[4];
#pragma unroll
        for (int q = 0; q < 4; ++q) expert_item<WHICH>(F, l, it + q * nw, src[q], gain[q], dst[q]);
        tr_items16<4>(src, ldw, gain, dst, ldt, (LAS unsigned short*)scr, F.lane); }
    for (; it + nw < NIT; it += 2 * nw) { const float* src[2]; const float* gain[2]; bf16* dst[2];
        expert_item<WHICH>(F, l, it, src[0], gain[0], dst[0]); expert_item<WHICH>(F, l, it + nw, src[1], gain[1], dst[1]);
        tr_items<2>(src, ldw, gain, dst, ldt, scr, F.lane); }
    for (; it < NIT; it += nw) { const float* src[1]; const float* gain[1]; bf16* dst[1];
        expert_item<WHICH>(F, l, it, src[0], gain[0], dst[0]); tr_items<1>(src, ldw, gain, dst, ldt, scr, F.lane); }
}
__device__ __forceinline__ void pool_item(const float* win, const float* wpool, const float* pscale, const float* gain, bf16* dst, int kb8, int nb, int lane) {
    const int k0 = 8 * kb8, n0 = 32 * nb, g = n0 >> 6, d0 = n0 & 63, nn = lane & 31, kh = lane >> 5;
    const float* wp = wpool + (size_t)g * 64 * 64 + d0 + nn; const float ps = pscale[n0 + nn];
    float wpr[64];
#pragma unroll
    for (int c = 0; c < 64; ++c) wpr[c] = wp[(size_t)c * 64];
    float r[4];
#pragma unroll
    for (int i = 0; i < 4; ++i) { const int kk = 4 * kh + i; const GAS f32x4* wr = (const GAS f32x4*)(win + (size_t)(k0 + kk) * INC + 416 + 64 * g); float a = 0.f;
#pragma unroll
        for (int hh = 0; hh < 4; ++hh) { f32x4 w4[4];
#pragma unroll
            for (int c = 0; c < 4; ++c) w4[c] = wr[4 * hh + c];
#pragma unroll
            for (int c = 0; c < 4; ++c) a += w4[c].x * wpr[16 * hh + 4 * c] + w4[c].y * wpr[16 * hh + 4 * c + 1] + w4[c].z * wpr[16 * hh + 4 * c + 2] + w4[c].w * wpr[16 * hh + 4 * c + 3];
            asm volatile("" ::: "memory"); }
        r[i] = a * ps * gain[k0 + kk]; }
    float o[4];
#pragma unroll
    for (int i = 0; i < 4; ++i) o[i] = __shfl_xor(r[i], 32);
    if (kh == 0) *(GAS v4u*)(dst + (size_t)(UC_POOL + n0 + nn) * D + k0) = (v4u){pk2(r[0], r[1]), pk2(r[2], r[3]), pk2(o[0], o[1]), pk2(o[2], o[3])};
}
__device__ __forceinline__ void zero_bf16(bf16* p, int n, int lane) { unsigned z = 0u; asm volatile("" : "+v"(z)); for (int i = lane * 8; i < n; i += 512) *(GAS v4u*)(p + i) = (v4u){z, z, z, z}; }

template <bool POOL = true> __device__ __forceinline__ void prep_weights(const Frame& F, int l0, int nl, int lo, int hi, int w0, int nw) {
    LAS float* scr = (LAS float*)(F.lds + RING_OFF + F.wave * 17408);
    const int span = hi - lo;
    for (int it0 = w0; it0 < nl * span; it0 += nw) {
        int lane = F.lane; asm volatile("" : "+v"(lane));
        const int l = l0 + it0 / span; int r = lo + it0 % span;
        unsigned char* wl = F.ws + WS_W + (size_t)l * 57 * MiB;
        bf16* Bin = (bf16*)(wl + WL_IN); bf16* Bup = (bf16*)(wl + WL_UP);
        const float* g_mix = (const float*)ARGP(3) + (size_t)l * D;
        const float* win = (const float*)ARGP(4) + (size_t)l * D * INC;
        if (r < IT_GU) { const int e = r >> 8, q = r & 255, which = q >> 7, q2 = q & 127, kb = q2 >> 3, nb = q2 & 7, n0 = 32 * nb;
            const float* W = (const float*)ARGP(which ? 33 : 32) + ((size_t)l * NEXP + e) * D * DEXP;
            bf16* dst = (bf16*)(wl + WL_GU) + ((size_t)e * 512 + 256 * (n0 >> 7) + 128 * which + (n0 & 127)) * D + 64 * kb;
            tr_item(W + (size_t)(64 * kb) * DEXP + n0, DEXP, (const float*)ARGP(27) + (size_t)l * D + 64 * kb, dst, D, scr, lane); continue; } r -= IT_GU;
        if (r < IT_DN) { const int e = r >> 7, q = r & 127, kb = q >> 5, nb = q & 31;
            const float* W = (const float*)ARGP(34) + ((size_t)l * NEXP + e) * DEXP * D;
            bf16* dst = (bf16*)(wl + WL_DN) + ((size_t)e * D + 32 * nb) * DEXP + 64 * kb;
            tr_item(W + (size_t)(64 * kb) * D + 32 * nb, D, nullptr, dst, DEXP, scr, lane); continue; } r -= IT_DN;
        if (r < IT_IN) { const int kb = r / 53, j = r % 53, ob = j < 13 ? j : j + 8, on0 = 32 * ob, nn0 = on0 + (ob >= 13 ? 96 : 0);
            tr_item(win + (size_t)(64 * kb) * INC + on0, INC, g_mix + 64 * kb, Bin + (size_t)nn0 * D + 64 * kb, D, scr, lane); continue; } r -= IT_IN;
        if (POOL && r < IT_POOL) { pool_item(win, (const float*)ARGP(11) + (size_t)l * 4 * 64 * 64, (const float*)ARGP(12) + (size_t)l * 256, g_mix, Bin, r >> 3, r & 7, lane); continue; } r -= IT_POOL;
        if (r < IT_ZIN) { zero_bf16(Bin + (size_t)(416 + r) * D, D, lane); continue; } r -= IT_ZIN;
        if (r < IT_UQ) { const int kb = r / 12, nb = r % 12;
            tr_item((const float*)ARGP(6) + (size_t)l * 256 * 384 + (size_t)(64 * kb) * 384 + 32 * nb, 384, (const float*)ARGP(5) + (size_t)l * 256 + 64 * kb, Bup + (size_t)(32 * nb) * 384 + 64 * kb, 384, scr, lane); continue; } r -= IT_UQ;
        if (r < IT_UKV) { const int kb = r / 16, nb = r % 16;
            tr_item((const float*)ARGP(8) + (size_t)l * 128 * 512 + (size_t)(64 * kb) * 512 + 32 * nb, 512, (const float*)ARGP(7) + (size_t)l * 128 + 64 * kb, Bup + (size_t)(512 + 32 * nb) * 384 + 256 + 64 * kb, 384, scr, lane); continue; } r -= IT_UKV;
        if (r < IT_ZUP) { bf16* row = Bup + (size_t)r * 384;
            if (r < 384) zero_bf16(row + 256, 128, lane); else if (r < 512) zero_bf16(row, 384, lane); else zero_bf16(row, 256, lane);
            continue; } r -= IT_ZUP;
        if (r < IT_MIX) { const int kb = r >> 5, nb = r & 31;
            tr_item((const float*)ARGP(19) + (size_t)l * D * D + (size_t)(64 * kb) * D + 32 * nb, D, (const float*)ARGP(18) + (size_t)l * D + 64 * kb, (bf16*)(wl + WL_MIX) + (size_t)(32 * nb) * D + 64 * ((kb & 3) + 4 * ((0x3120 >> (4 * (kb >> 2))) & 3)), D, scr, lane); continue; } r -= IT_MIX;
        if (r < IT_XQ) { const int kb = r >> 3, nb = r & 7;
            tr_item((const float*)ARGP(22) + (size_t)l * D * 256 + (size_t)(64 * kb) * 256 + 32 * nb, 256, (const float*)ARGP(20) + (size_t)l * D + 64 * kb, (bf16*)(wl + WL_XQ) + (size_t)(32 * nb) * D + 64 * kb, D, scr, lane); continue; } r -= IT_XQ;
        if (r < IT_XKV) { const int kb = r >> 4, nb = r & 15;
            tr_item((const float*)ARGP(23) + (size_t)l * D * 512 + (size_t)(64 * kb) * 512 + 32 * nb, 512, (const float*)ARGP(21) + (size_t)l * D + 64 * kb, (bf16*)(F.ws + WS_XKV) + (size_t)(512 * l + 32 * nb) * D + 64 * kb, D, scr, lane); continue; } r -= IT_XKV;
        if (r < IT_XO) { const int kb = r >> 5, nb = r & 31;
            tr_item((const float*)ARGP(26) + (size_t)l * 256 * D + (size_t)(64 * kb) * D + 32 * nb, D, nullptr, (bf16*)(wl + WL_XO) + (size_t)(32 * nb) * 256 + 64 * kb, 256, scr, lane); continue; } r -= IT_XO;
        const float* g_ffn = (const float*)ARGP(27) + (size_t)l * D;
        if (r < IT_RE) { const int kb = r;
            tr_item((const float*)ARGP(30) + (size_t)l * D * 32 + (size_t)(64 * kb) * 32, 32, g_ffn + 64 * kb, (bf16*)(wl + WL_R) + (size_t)4 * D + 64 * kb, D, scr, lane); continue; } r -= IT_RE;
        { const int k = 64 * r + lane; const float* wg = (const float*)ARGP(28) + (size_t)l * D * 4 + (size_t)k * 4; const float gv = g_ffn[k]; bf16* dst = (bf16*)(wl + WL_R);
#pragma unroll
          for (int n = 0; n < 4; ++n) dst[(size_t)n * D + k] = (bf16)f2bf(wg[n] * gv); }
    }
}
template <int UNR, bool NORM> __device__ __forceinline__ void rows_to_bf16(const float* x, bf16* o, float* stat, int row0, int rstride, int lane) {
    f32x4 v[UNR][4];
#pragma unroll
    for (int u = 0; u < UNR; ++u) { const GAS f32x4* xr = (const GAS f32x4*)(x + (size_t)(row0 + u * rstride) * D) + lane;
#pragma unroll
        for (int j = 0; j < 4; ++j) v[u][j] = xr[64 * j]; }
#pragma unroll
    for (int u = 0; u < UNR; ++u) { float ss = 0.f; const int row = row0 + u * rstride;
#pragma unroll
        for (int j = 0; j < 4; ++j) ss += (v[u][j].x * v[u][j].x + v[u][j].y * v[u][j].y) + (v[u][j].z * v[u][j].z + v[u][j].w * v[u][j].w);
        ss = wave_sum(ss);
        float r = 1.0f;
        if (NORM) r = 1.0f / sqrtf(ss * (1.f / D) + EPS);
        else if (lane < 16) stat[(size_t)row * 16 + lane] = (lane == 0) ? ss : 0.f;
        GAS v2u* o8 = (GAS v2u*)(o + (size_t)row * D) + lane;
#pragma unroll
        for (int j = 0; j < 4; ++j) o8[64 * j] = (v2u){pk2(v[u][j].x * r, v[u][j].y * r), pk2(v[u][j].z * r, v[u][j].w * r)}; }
}
template <bool NORM> __device__ __forceinline__ void rows_pass(const Frame& F, const float* x, bf16* o, float* stat, int nrows) {
    int m = F.gw;
    for (; m + 3 * F.NGW < nrows; m += 4 * F.NGW) rows_to_bf16<4, NORM>(x, o, stat, m, F.NGW, F.lane);
    for (; m < nrows; m += F.NGW) rows_to_bf16<1, NORM>(x, o, stat, m, F.NGW, F.lane);
}

constexpr int AL_K = 0, AL_KSZ = 12288, AL_V = 2 * AL_KSZ, AL_VSZ = 8192, AL_WS = AL_V + 2 * AL_VSZ, AL_OST = AL_WS + 8 * 256, AL_END = AL_OST + 8 * 4096;
static_assert(AL_END <= RING_BYTES, "attention LDS");
__device__ __forceinline__ int crow(int r, int hi) { return (r & 3) + 8 * (r >> 2) + 4 * hi; }
__device__ __forceinline__ unsigned cvtpk(float lo, float hi) { unsigned r; asm volatile("v_cvt_pk_bf16_f32 %0, %1, %2" : "=v"(r) : "v"(lo), "v"(hi)); return r; }

__device__ __forceinline__ float max3f(float a, float b, float c) { float r; asm("v_max3_f32 %0, %1, %2, %3" : "=v"(r) : "v"(a), "v"(b), "v"(c)); return r; }
__device__ __forceinline__ float max2f(float a, float b) { float r; asm("v_max_f32_e32 %0, %1, %2" : "=v"(r) : "v"(a), "v"(b)); return r; }
struct AttnWave {
    const bf16* Q; int ldq;
    bf16* O; int ldo;
    const bf16* K0; const bf16* K1; int ldk;
    const bf16* V; int ldv;
    int NT;
    int qpos0;
    float sink;
    const float* qgain; float qscale;
    const int* pos;
    unsigned* oflag;
    float kbound;
    float* st;
};
typedef float f32x2 __attribute__((ext_vector_type(2)));
typedef __bf16 bf16x2_t __attribute__((ext_vector_type(2)));
__device__ __forceinline__ unsigned cvtpk_m(float lo, float hi) { return __builtin_bit_cast(unsigned, __builtin_convertvector((f32x2){lo, hi}, bf16x2_t)); }
__device__ __forceinline__ f32x2 pk_add2(f32x2 a, f32x2 b) { f32x2 r; asm("v_pk_add_f32 %0, %1, %2" : "=v"(r) : "v"(a), "v"(b)); return r; }
__device__ __forceinline__ float wave_absmax(const float* g, int n, int lane) { float v = 0.f; for (int i = lane; i < n; i += 64) v = fmaxf(v, fabsf(g[i]));
    for (int o = 32; o > 0; o >>= 1) v = fmaxf(v, __shfl_xor(v, o)); return __builtin_bit_cast(float, __builtin_amdgcn_readfirstlane(__builtin_bit_cast(int, v))); }
template <int MASK> __device__ __forceinline__ bool att_active(int kt, int qpos0) {
    if (MASK == 1) return kt * 64 <= qpos0 + 31;
    if (MASK == 2) return (kt * 64 <= qpos0 + 31) && (kt * 64 + 63 > qpos0 - 128);
    return true;
}
template <int ND0> __device__ __forceinline__ void att_qk(const LAS unsigned char* kb, const bf16x8 (&qr)[ND0], f32x16& n0, f32x16& n1) {
    const f32x16 negm = {};
    bf16x8 kf[2 * ND0];
#pragma unroll
    for (int d0 = 0; d0 < ND0; ++d0) { kf[2 * d0] = *(const LAS bf16x8*)(kb + d0 * 2048); kf[2 * d0 + 1] = *(const LAS bf16x8*)(kb + d0 * 2048 + 512); }
    n0 = __builtin_amdgcn_mfma_f32_32x32x16_bf16(kf[0], qr[0], negm, 0, 0, 0); n1 = __builtin_amdgcn_mfma_f32_32x32x16_bf16(kf[1], qr[0], negm, 0, 0, 0);
#pragma unroll
    for (int d0 = 1; d0 < ND0; ++d0) {
        n0 = __builtin_amdgcn_mfma_f32_32x32x16_bf16(kf[2 * d0], qr[d0], n0, 0, 0, 0);
        n1 = __builtin_amdgcn_mfma_f32_32x32x16_bf16(kf[2 * d0 + 1], qr[d0], n1, 0, 0, 0); }
    asm volatile("s_nop 15\n\ts_nop 7" : "+v"(n0), "+v"(n1));
}
template <int ND0, int MASK, bool FUSED, bool NOREF>
__device__ __forceinline__ void att_body(const LAS unsigned char* kb, const LAS unsigned char* vb, const bf16x8 (&qr)[ND0], int kt, int qpos0, int r32, int hi, LAS float* wsf,
                                         f32x16& c0, f32x16& c1, f32x16& n0, f32x16& n1, f32x16& o0, f32x16& o1, float& m_run, float& l_run, bool& first) {
    constexpr int NDA = ND0 / 2, NDB = ND0 - NDA; const f32x16 negm = {};
    bf16x8 ka[2 * NDA], kq[2 * NDB];
    if constexpr (FUSED) {
#pragma unroll
        for (int d0 = 0; d0 < NDA; ++d0) { ka[2 * d0] = *(const LAS bf16x8*)(kb + d0 * 2048); ka[2 * d0 + 1] = *(const LAS bf16x8*)(kb + d0 * 2048 + 512); } }
    if (MASK != 0) {
        const int q = qpos0 + r32;
        bool need = (kt * 64 + 63 > qpos0);
        if (MASK == 2) need = need || (kt * 64 <= qpos0 + 31 - 128);
        if (need) {
#pragma unroll
            for (int r = 0; r < 16; ++r) { const int k0i = kt * 64 + crow(r, hi), k1i = k0i + 32;
                bool bad0 = k0i > q, bad1 = k1i > q;
                if (MASK == 2) { bad0 = bad0 || (k0i <= q - 128); bad1 = bad1 || (k1i <= q - 128); }
                if (bad0) c0[r] = -INFINITY; if (bad1) c1[r] = -INFINITY; }
        }
    }
    if constexpr (!NOREF) {
    float mx;
    { float a = max3f(c0[0], c0[1], c1[0]), b = max3f(c0[2], c0[3], c1[1]); a = max3f(a, c1[2], c1[3]);
#pragma unroll
      for (int r = 4; r < 16; r += 4) { a = max3f(a, c0[r], c0[r + 1]); b = max3f(b, c0[r + 2], c0[r + 3]); a = max3f(a, c1[r], c1[r + 1]); b = max3f(b, c1[r + 2], c1[r + 3]); }
      mx = max2f(a, b); mx = max2f(mx, __shfl_xor(mx, 32)) - m_run; }
    if (first || __any(mx > 8.0f)) {
        const float dl = (mx == -INFINITY) ? 0.f : (first ? mx : fmaxf(mx, 0.f));
        first = false;
        m_run += dl;
        const float alpha = __builtin_amdgcn_exp2f(-dl);
        l_run *= alpha;
        if (hi == 0) wsf[r32] = alpha;
        asm volatile("s_waitcnt lgkmcnt(0)" ::: "memory");
#pragma unroll
        for (int g = 0; g < 4; ++g) { const f32x4 a4 = *(const LAS f32x4*)(wsf + 8 * g + 4 * hi);
#pragma unroll
            for (int j = 0; j < 4; ++j) { o0[4 * g + j] *= a4[j]; o1[4 * g + j] *= a4[j]; } }
        asm volatile("" ::: "memory");
    }
    }
    const f32x2 nm2 = (f32x2){-m_run, -m_run}; (void)nm2;
    __builtin_amdgcn_sched_barrier(0);
    if constexpr (FUSED) {
        n0 = __builtin_amdgcn_mfma_f32_32x32x16_bf16(ka[0], qr[0], negm, 0, 0, 0); n1 = __builtin_amdgcn_mfma_f32_32x32x16_bf16(ka[1], qr[0], negm, 0, 0, 0);
#pragma unroll
        for (int d0 = 1; d0 < NDA; ++d0) {
            n0 = __builtin_amdgcn_mfma_f32_32x32x16_bf16(ka[2 * d0], qr[d0], n0, 0, 0, 0);
            n1 = __builtin_amdgcn_mfma_f32_32x32x16_bf16(ka[2 * d0 + 1], qr[d0], n1, 0, 0, 0); } }
#pragma unroll
    for (int r = 0; r < 16; r += 2) {
        if constexpr (NOREF) { c0[r] = __builtin_amdgcn_exp2f(c0[r]); c0[r + 1] = __builtin_amdgcn_exp2f(c0[r + 1]); }
        else { const f32x2 t2 = pk_add2((f32x2){c0[r], c0[r + 1]}, nm2); c0[r] = __builtin_amdgcn_exp2f(t2[0]); c0[r + 1] = __builtin_amdgcn_exp2f(t2[1]); }
        l_run += c0[r]; l_run += c0[r + 1]; }
    if constexpr (FUSED) {
#pragma unroll
        for (int d0 = 0; d0 < NDB; ++d0) { kq[2 * d0] = *(const LAS bf16x8*)(kb + (NDA + d0) * 2048); kq[2 * d0 + 1] = *(const LAS bf16x8*)(kb + (NDA + d0) * 2048 + 512); }
#define SGB_MT(n) __builtin_amdgcn_sched_group_barrier(0x008, 1, 0); __builtin_amdgcn_sched_group_barrier(0x400, n, 0);
        __builtin_amdgcn_sched_group_barrier(0x400, 4, 0);
        if constexpr (NDA == 3) { SGB_MT(2) SGB_MT(2) SGB_MT(2) SGB_MT(2) SGB_MT(2) SGB_MT(2) } else { SGB_MT(3) SGB_MT(3) SGB_MT(3) SGB_MT(3) }
        __builtin_amdgcn_sched_group_barrier(0x100, 2 * NDB, 0);
    }
    __builtin_amdgcn_sched_barrier(0);
    s16x4 vl[8], vh[8];
#pragma unroll
    for (int i = 0; i < 4; ++i) { const int off = i * 1024;
        vl[i] = __builtin_bit_cast(s16x4, __builtin_amdgcn_ds_read_tr16_b64_v4i16((LAS s16x4*)(vb + off)));
        vh[i] = __builtin_bit_cast(s16x4, __builtin_amdgcn_ds_read_tr16_b64_v4i16((LAS s16x4*)(vb + off + 512))); }
    if constexpr (FUSED) {
#pragma unroll
        for (int d0 = 0; d0 < NDB; ++d0) {
            n0 = __builtin_amdgcn_mfma_f32_32x32x16_bf16(kq[2 * d0], qr[NDA + d0], n0, 0, 0, 0);
            n1 = __builtin_amdgcn_mfma_f32_32x32x16_bf16(kq[2 * d0 + 1], qr[NDA + d0], n1, 0, 0, 0); } }
#pragma unroll
    for (int r = 0; r < 16; r += 2) {
        if constexpr (NOREF) { c1[r] = __builtin_amdgcn_exp2f(c1[r]); c1[r + 1] = __builtin_amdgcn_exp2f(c1[r + 1]); }
        else { const f32x2 t2 = pk_add2((f32x2){c1[r], c1[r + 1]}, nm2); c1[r] = __builtin_amdgcn_exp2f(t2[0]); c1[r + 1] = __builtin_amdgcn_exp2f(t2[1]); }
        l_run += c1[r]; l_run += c1[r + 1]; }
    if constexpr (FUSED) {
        __builtin_amdgcn_sched_group_barrier(0x100, 8, 0); __builtin_amdgcn_sched_group_barrier(0x400, 4, 0);
        if constexpr (NDB == 3) { SGB_MT(2) SGB_MT(2) SGB_MT(2) SGB_MT(2) SGB_MT(2) SGB_MT(2) } else { SGB_MT(3) SGB_MT(3) SGB_MT(3) SGB_MT(3) }
#undef SGB_MT
    }
    v4u pw[4];
    pw[0] = (v4u){cvtpk_m(c0[0], c0[1]), cvtpk_m(c0[2], c0[3]), cvtpk_m(c0[4], c0[5]), cvtpk_m(c0[6], c0[7])};
    pw[1] = (v4u){cvtpk_m(c0[8], c0[9]), cvtpk_m(c0[10], c0[11]), cvtpk_m(c0[12], c0[13]), cvtpk_m(c0[14], c0[15])};
    pw[2] = (v4u){cvtpk_m(c1[0], c1[1]), cvtpk_m(c1[2], c1[3]), cvtpk_m(c1[4], c1[5]), cvtpk_m(c1[6], c1[7])};
    pw[3] = (v4u){cvtpk_m(c1[8], c1[9]), cvtpk_m(c1[10], c1[11]), cvtpk_m(c1[12], c1[13]), cvtpk_m(c1[14], c1[15])};
    __builtin_amdgcn_sched_barrier(0);
#pragma unroll
    for (int i = 4; i < 8; ++i) { const int off = 4096 + (i & 3) * 1024;
        vl[i] = __builtin_bit_cast(s16x4, __builtin_amdgcn_ds_read_tr16_b64_v4i16((LAS s16x4*)(vb + off)));
        vh[i] = __builtin_bit_cast(s16x4, __builtin_amdgcn_ds_read_tr16_b64_v4i16((LAS s16x4*)(vb + off + 512))); }
#pragma unroll
    for (int ks = 0; ks < 4; ++ks) {
        const bf16x8 v0 = (bf16x8){vl[ks][0], vl[ks][1], vl[ks][2], vl[ks][3], vh[ks][0], vh[ks][1], vh[ks][2], vh[ks][3]};
        o0 = __builtin_amdgcn_mfma_f32_32x32x16_bf16(__builtin_bit_cast(bf16x8, pw[ks]), v0, o0, 0, 0, 0); }
#pragma unroll
    for (int ks = 0; ks < 4; ++ks) {
        const bf16x8 v1 = (bf16x8){vl[4 + ks][0], vl[4 + ks][1], vl[4 + ks][2], vl[4 + ks][3], vh[4 + ks][0], vh[4 + ks][1], vh[4 + ks][2], vh[4 + ks][3]};
        o1 = __builtin_amdgcn_mfma_f32_32x32x16_bf16(__builtin_bit_cast(bf16x8, pw[ks]), v1, o1, 0, 0, 0); }
}
template <int DQK, int MASK, bool QNORM, bool PUB, bool NOREF>
__device__ __forceinline__ void attn_unit(LAS unsigned char* lds, const AttnWave& W) {
    constexpr int ND0 = DQK / 16, NCH = DQK / 8;
    const int tid = tid_now(), lane = tid & 63, r32 = lane & 31, hi = lane >> 5; const int wid = __builtin_amdgcn_readfirstlane(tid >> 6);
    LAS float* wsf = (LAS float*)(lds + AL_WS) + wid * 64;
    bf16x8 qr[ND0];
#pragma unroll
    for (int d0 = 0; d0 < ND0; ++d0) qr[d0] = *(const GAS bf16x8*)(W.Q + (size_t)r32 * W.ldq + d0 * 16 + hi * 8);
    if constexpr (QNORM) {
        float qf[ND0][8]; float ss = 0.f;
#pragma unroll
        for (int d0 = 0; d0 < ND0; ++d0)
#pragma unroll
            for (int j = 0; j < 8; ++j) { qf[d0][j] = bf2f((unsigned short)qr[d0][j]); ss += qf[d0][j] * qf[d0][j]; }
        ss += __shfl_xor(ss, 32);
        const float r = __builtin_amdgcn_rsqf(ss * (1.0f / DQK) + EPS) * W.qscale;
#pragma unroll
        for (int d0 = 0; d0 < ND0; ++d0)
#pragma unroll
            for (int j = 0; j < 8; ++j) qf[d0][j] *= r * W.qgain[d0 * 16 + hi * 8 + j];
        if constexpr (DQK == 96) {
            const double p = (double)W.pos[r32];
#pragma unroll
            for (int j = 0; j < 8; ++j) { const int i = 8 * hi + j;
                const double rev = p * ((double)exp2f(-(float)i * (13.287712379549449f / 16.0f)) * 0.15915494309189535); const float fr = (float)(rev - __builtin_rint(rev));
                const float sn = __builtin_amdgcn_sinf(fr), cs = __builtin_amdgcn_cosf(fr);
                const float x1 = qf[4][j], x2 = qf[5][j]; qf[4][j] = x1 * cs - x2 * sn; qf[5][j] = x2 * cs + x1 * sn; } }
#pragma unroll
        for (int d0 = 0; d0 < ND0; ++d0) {
            v4u w;
            w.x = cvtpk(qf[d0][0], qf[d0][1]); w.y = cvtpk(qf[d0][2], qf[d0][3]); w.z = cvtpk(qf[d0][4], qf[d0][5]); w.w = cvtpk(qf[d0][6], qf[d0][7]);
            qr[d0] = __builtin_bit_cast(bf16x8, w); }
    }
    const int kc0 = wid, kc1 = wid + 8;
    const bool has2 = (kc1 < NCH);
    const bf16* ksrc0 = W.K0 + (size_t)lane * W.ldk + 8 * kc0;
    const bf16* ksrc1 = W.K1 + (size_t)lane * W.ldk + 8 * (kc1 - 8);
    const bf16* vsrc = W.V + (size_t)(16 * (wid & 3) + (lane >> 2)) * W.ldv + 32 * (wid >> 2) + 8 * (lane & 3);
    const size_t kstep = (size_t)64 * W.ldk, vstep = (size_t)64 * W.ldv;
    const int kdst0 = AL_K + kc0 * 1024 + lane * 16, kdst1 = AL_K + kc1 * 1024 + lane * 16, vdst = AL_V + wid * 1024 + lane * 16;
    const int kfrag = AL_K + hi * 1024 + r32 * 16;
    const int vfrag = AL_V + ((lane >> 4) & 1) * 32 + (lane & 3) * 8 + (4 * hi + ((lane & 15) >> 2)) * 64;
    v4u kreg0, kreg1 = (v4u){0u, 0u, 0u, 0u}, vreg;
    kreg0 = *(const GAS v4u*)ksrc0; if (has2) kreg1 = *(const GAS v4u*)ksrc1; vreg = *(const GAS v4u*)vsrc;
    *(LAS v4u*)(lds + kdst0) = kreg0; if (has2) *(LAS v4u*)(lds + kdst1) = kreg1; *(LAS v4u*)(lds + vdst) = vreg;
    kreg0 = *(const GAS v4u*)(ksrc0 + kstep); if (has2) kreg1 = *(const GAS v4u*)(ksrc1 + kstep);
    *(LAS v4u*)(lds + kdst0 + AL_KSZ) = kreg0; if (has2) *(LAS v4u*)(lds + kdst1 + AL_KSZ) = kreg1;
    __syncthreads();
    float m_run = 0.f, l_run = 0.f; f32x16 o0 = {}, o1 = {}; bool first = true;
    f32x16 sa0 = {}, sa1 = {}, sb0 = {}, sb1 = {};
    int t_hi = W.NT - 1, t_lo = 0;
    if (MASK != 0) { const int th = (W.qpos0 + 31) >> 6; t_hi = th < t_hi ? th : t_hi; }
    if (MASK == 2) { const int tl = (W.qpos0 - 127) >> 6; t_lo = tl > 0 ? tl : 0; }
    if (t_lo == 0) att_qk<ND0>(lds + kfrag, qr, sa0, sa1);
    asm volatile("s_waitcnt lgkmcnt(0)" ::: "memory");
    __syncthreads();
#define ATT_LOADS(KT) const int kt_ = (KT); const int buf_ = kt_ & 1;                                                                                   \
               \
        const bool more1_ = (MASK == 1) || (kt_ + 1 < W.NT), more2_ = (MASK == 1) || (kt_ + 2 < W.NT);                                              \
        const int k2_ = (MASK == 1) ? (kt_ + 2 < W.NT ? kt_ + 2 : W.NT - 1) : kt_ + 2, v1_ = (MASK == 1) ? (kt_ + 1 < W.NT ? kt_ + 1 : W.NT - 1) : kt_ + 1; \
        if (more2_) { kreg0 = *(const GAS v4u*)(ksrc0 + (size_t)k2_ * kstep); if (has2) kreg1 = *(const GAS v4u*)(ksrc1 + (size_t)k2_ * kstep); }   \
        if (more1_) vreg = *(const GAS v4u*)(vsrc + (size_t)v1_ * vstep);                                                                           \
        const LAS unsigned char* kb_ = lds + kfrag + (buf_ ^ 1) * AL_KSZ; const LAS unsigned char* vb_ = lds + vfrag + buf_ * AL_VSZ; (void)kb_; (void)vb_;
#define ATT_STORES()                                                                                                                                \
        if (more2_) { *(LAS v4u*)(lds + kdst0 + buf_ * AL_KSZ) = kreg0; if (has2) *(LAS v4u*)(lds + kdst1 + buf_ * AL_KSZ) = kreg1; }               \
        if (more1_) *(LAS v4u*)(lds + vdst + (buf_ ^ 1) * AL_VSZ) = vreg;                                                                           \
        __syncthreads();
#define ATT_FUSED(KT, C0, C1, N0, N1) do { ATT_LOADS(KT)                                                                                            \
        att_body<ND0, MASK, true, NOREF>(kb_, vb_, qr, kt_, W.qpos0, r32, hi, wsf, C0, C1, N0, N1, o0, o1, m_run, l_run, first);              \
        ATT_STORES() } while (0)
    int kt = 0;
#pragma unroll 1
    for (; kt < t_lo; ++kt) { ATT_LOADS(kt) if (kt_ == t_lo - 1) att_qk<ND0>(kb_, qr, sa0, sa1); ATT_STORES() }
#pragma unroll 1
    for (; kt + 1 < t_hi; kt += 2) { ATT_FUSED(kt, sa0, sa1, sb0, sb1); ATT_FUSED(kt + 1, sb0, sb1, sa0, sa1); }
    if (kt < t_hi) { ATT_FUSED(kt, sa0, sa1, sb0, sb1); sa0 = sb0; sa1 = sb1; ++kt; }
    { ATT_LOADS(kt) att_body<ND0, MASK, false, NOREF>(kb_, vb_, qr, kt_, W.qpos0, r32, hi, wsf, sa0, sa1, sb0, sb1, o0, o1, m_run, l_run, first); ATT_STORES() }
    ++kt;
#pragma unroll 1
    for (; kt < W.NT; ++kt) { ATT_LOADS(kt) ATT_STORES() }
#undef ATT_FUSED
#undef ATT_STORES
#undef ATT_LOADS
    l_run += __shfl_xor(l_run, 32);
    if (W.sink > -INFINITY) l_run += __builtin_amdgcn_exp2f(W.sink - m_run);
    if (hi == 0) wsf[32 + r32] = __builtin_amdgcn_rcpf(l_run);
    asm volatile("s_waitcnt lgkmcnt(0)" ::: "memory");
    LAS bf16* stg = (LAS bf16*)(lds + AL_OST) + wid * 2048;
#pragma unroll
    for (int g = 0; g < 4; ++g) { const f32x4 a4 = *(const LAS f32x4*)(wsf + 32 + 8 * g + 4 * hi);
#pragma unroll
        for (int j = 0; j < 4; ++j) { const int orow = 8 * g + 4 * hi + j;
            stg[orow * 64 + r32] = (bf16)f2bf(o0[4 * g + j] * a4[j]); stg[orow * 64 + 32 + r32] = (bf16)f2bf(o1[4 * g + j] * a4[j]); } }
    asm volatile("s_waitcnt lgkmcnt(0)" ::: "memory");
#pragma unroll
    for (int i = 0; i < 4; ++i) { const int row = i * 8 + (lane >> 3), ch = lane & 7; const v4u v = *(const LAS v4u*)(stg + row * 64 + ch * 8); if constexpr (PUB) pg8::st_wt16(W.O + (size_t)row * W.ldo + ch * 8, v); else *(GAS v4u*)(W.O + (size_t)row * W.ldo + ch * 8) = v;
        if (W.st) { float ss = bflo(v.x) * bflo(v.x) + bfhi(v.x) * bfhi(v.x) + bflo(v.y) * bflo(v.y) + bfhi(v.y) * bfhi(v.y) + bflo(v.z) * bflo(v.z) + bfhi(v.z) * bfhi(v.z) + bflo(v.w) * bflo(v.w) + bfhi(v.w) * bfhi(v.w);
            ss += __shfl_xor(ss, 1); ss += __shfl_xor(ss, 2); ss += __shfl_xor(ss, 4);
            if (ch == 0) W.st[4 * row] = ss; } }
    if constexpr (PUB) pg8::flag_arrive(W.oflag, lane);
    __syncthreads();
}

struct T3Const { float gqv[6], gkv[6], sgqv[4], sgkv[4], cwv[3][4], cbv[4]; double invf; };
template <int UNR, int PART> __device__ __forceinline__ void t3_tokens(const Frame& F, const T3Const& C, int t0, int tstride, bool dry) {
    const int lane = F.lane, h = lane >> 4, sub = lane & 15, kh = h & 1;
    bf16* U = (bf16*)(F.ws + WS_U); bf16* QKV = (bf16*)(F.ws + WS_QKV); bf16* Y = (bf16*)(F.ws + WS_Y);
    const int* positions = (const int*)ARGP(2);
    const int c0 = 4 * lane, pg = lane >> 4, pw = 2 << pg;
    unsigned short kv[UNR][6], sk[UNR][4]; v2u pl[UNR][16], cc[UNR][3], chh[UNR][3], cbg[UNR]; int pos[UNR];
#pragma unroll
    for (int u = 0; u < UNR; ++u) { const int t = t0 + u * tstride, s = t & (SEQ - 1);
        const bf16* qrow = QKV + (size_t)t * 1024; const bf16* urow = U + (size_t)t * UW;
        if (PART == 0) {
        pos[u] = positions[t];
#pragma unroll
        for (int j = 0; j < 4; ++j) kv[u][j] = qrow[QC_KV + 128 * h + sub + 16 * j];
        kv[u][4] = urow[UC_ROPE + sub]; kv[u][5] = urow[UC_ROPE + 16 + sub];
#pragma unroll
        for (int j = 0; j < 4; ++j) sk[u][j] = urow[UC_SK + 64 * kh + sub + 16 * j];
        } else {
#pragma unroll
        for (int tau = 0; tau < 16; ++tau) { const int back = (tau < s) ? tau : s; pl[u][tau] = *(const GAS v2u*)(urow - (size_t)back * UW + UC_POOL + c0); }
#pragma unroll
        for (int tau = 0; tau < 3; ++tau) { const int back = (tau < s) ? tau : s; cc[u][tau] = *(const GAS v2u*)(urow - (size_t)back * UW + UC_CC + c0); chh[u][tau] = *(const GAS v2u*)(urow - (size_t)back * UW + UC_CH + c0); }
        cbg[u] = *(const GAS v2u*)(urow + UC_CB + c0);
        }
    }
#pragma unroll
    for (int u = 0; u < UNR; ++u) { const int t = t0 + u * tstride, s = t & (SEQ - 1);
        bf16* qrow = QKV + (size_t)t * 1024; bf16* urow = U + (size_t)t * UW;
        if (PART == 0) {
        const double rev = (double)pos[u] * C.invf; const float fr = (float)(rev - __builtin_rint(rev));
        const float sn = __builtin_amdgcn_sinf(fr), cs = __builtin_amdgcn_cosf(fr);
        {
            float v[6]; float ss = 0.f;
#pragma unroll
            for (int j = 0; j < 6; ++j) { v[j] = bf2f(kv[u][j]); ss += v[j] * v[j]; }
            const float r = __builtin_amdgcn_rsqf(sum16(ss) * (1.0f / 96.0f) + EPS);
#pragma unroll
            for (int j = 0; j < 6; ++j) v[j] *= r * C.gkv[j];
            const float x1 = v[4], x2 = v[5]; v[4] = x1 * cs - x2 * sn; v[5] = x2 * cs + x1 * sn;
#pragma unroll
            for (int j = 0; j < 4; ++j) qrow[QC_KV + 128 * h + sub + 16 * j] = dry ? kv[u][j] : (bf16)f2bf(v[j]);
            if (!dry) { qrow[QC_KR + 32 * h + sub] = (bf16)f2bf(v[4]); qrow[QC_KR + 32 * h + 16 + sub] = (bf16)f2bf(v[5]); }
        }
        {
            float v[4]; float ss = 0.f;
#pragma unroll
            for (int j = 0; j < 4; ++j) { v[j] = bf2f(sk[u][j]); ss += v[j] * v[j]; }
            const float rk = __builtin_amdgcn_rsqf(sum16(ss) * (1.0f / 64.0f) + EPS);
            if (lane < 32) {
#pragma unroll
                for (int j = 0; j < 4; ++j) urow[UC_SK + 64 * kh + sub + 16 * j] = dry ? sk[u][j] : (bf16)f2bf(v[j] * rk * C.sgkv[j]); }
        }
        } else {
        {
            const int cnt = (s + 1 < pw) ? (s + 1) : pw;
            float a[4] = {0.f, 0.f, 0.f, 0.f};
#pragma unroll
            for (int tau = 0; tau < 16; ++tau) { const float m = (tau < cnt) ? 1.0f : 0.0f; const v2u w = pl[u][tau];
                a[0] += m * bflo(w.x); a[1] += m * bfhi(w.x); a[2] += m * bflo(w.y); a[3] += m * bfhi(w.y); }
            const float u0[4] = {bflo(pl[u][0].x), bfhi(pl[u][0].x), bflo(pl[u][0].y), bfhi(pl[u][0].y)};
            const float ic = 1.0f / (float)cnt; float ss = 0.f;
#pragma unroll
            for (int j = 0; j < 4; ++j) { a[j] = a[j] * ic - u0[j]; ss += a[j] * a[j]; }
            const float r = __builtin_amdgcn_rsqf(wave_sum(ss) * (1.0f / 256.0f) + EPS);
            *(GAS v2u*)(Y + (size_t)t * 1024 + 512 + c0) = (v2u){pk2(a[0] * r, a[1] * r), pk2(a[2] * r, a[3] * r)};
        }
        {
            float z[3][4];
#pragma unroll
            for (int tau = 0; tau < 3; ++tau) { const float m = (s - tau >= 0) ? 1.0f : 0.0f; const v2u wc = cc[u][tau], wh = chh[u][tau];
                z[tau][0] = m * bflo(wc.x) * bflo(wh.x); z[tau][1] = m * bfhi(wc.x) * bfhi(wh.x); z[tau][2] = m * bflo(wc.y) * bflo(wh.y); z[tau][3] = m * bfhi(wc.y) * bfhi(wh.y); }
            const v2u wb = cbg[u]; const float bg[4] = {bflo(wb.x), bfhi(wb.x), bflo(wb.y), bfhi(wb.y)};
            float y[4]; float ss = 0.f;
#pragma unroll
            for (int j = 0; j < 4; ++j) { y[j] = bg[j] * (C.cwv[0][j] * z[2][j] + C.cwv[1][j] * z[1][j] + C.cwv[2][j] * z[0][j] + C.cbv[j]); ss += y[j] * y[j]; }
            const float r = __builtin_amdgcn_rsqf(wave_sum(ss) * (1.0f / 256.0f) + EPS);
            *(GAS v2u*)(Y + (size_t)t * 1024 + 768 + c0) = (v2u){pk2(y[0] * r, y[1] * r), pk2(y[2] * r, y[3] * r)};
        }
        }
    }
}
template <int UNR> __device__ __forceinline__ void t3_k_tokens(const Frame& F, const T3Const& C, int t0, int tstride, bool dry) {
    const int lane = F.lane, h = lane >> 4, sub = lane & 15, kh = h & 1;
    bf16* U = (bf16*)(F.ws + WS_U); bf16* QKV = (bf16*)(F.ws + WS_QKV);
    const int* positions = (const int*)ARGP(2);
    v2u kn[UNR], sk[UNR]; unsigned short kr[UNR][2]; int pos[UNR];
#pragma unroll
    for (int u = 0; u < UNR; ++u) { const int t = t0 + u * tstride;
        const bf16* qrow = QKV + (size_t)t * 1024; const bf16* urow = U + (size_t)t * UW;
        pos[u] = positions[t];
        kn[u] = *(const GAS v2u*)(qrow + QC_KV + 128 * h + 4 * sub);
        kr[u][0] = urow[UC_ROPE + sub]; kr[u][1] = urow[UC_ROPE + 16 + sub];
        sk[u] = *(const GAS v2u*)(urow + UC_SK + 64 * kh + 4 * sub); }
#pragma unroll
    for (int u = 0; u < UNR; ++u) { const int t = t0 + u * tstride;
        bf16* qrow = QKV + (size_t)t * 1024; bf16* urow = U + (size_t)t * UW;
        const double rev = (double)pos[u] * C.invf; const float fr = (float)(rev - __builtin_rint(rev));
        const float sn = __builtin_amdgcn_sinf(fr), cs = __builtin_amdgcn_cosf(fr);
        {
            float v[6] = {bflo(kn[u].x), bfhi(kn[u].x), bflo(kn[u].y), bfhi(kn[u].y), bf2f(kr[u][0]), bf2f(kr[u][1])}; float ss = 0.f;
#pragma unroll
            for (int j = 0; j < 6; ++j) ss += v[j] * v[j];
            const float r = __builtin_amdgcn_rsqf(sum16(ss) * (1.0f / 96.0f) + EPS);
#pragma unroll
            for (int j = 0; j < 6; ++j) v[j] *= r * C.gkv[j];
            const float x1 = v[4], x2 = v[5]; v[4] = x1 * cs - x2 * sn; v[5] = x2 * cs + x1 * sn;
            *(GAS v2u*)(qrow + QC_KV + 128 * h + 4 * sub) = dry ? kn[u] : (v2u){pk2(v[0], v[1]), pk2(v[2], v[3])};
            if (!dry) { qrow[QC_KR + 32 * h + sub] = (bf16)f2bf(v[4]); qrow[QC_KR + 32 * h + 16 + sub] = (bf16)f2bf(v[5]); }
        }
        {
            const float v[4] = {bflo(sk[u].x), bfhi(sk[u].x), bflo(sk[u].y), bfhi(sk[u].y)}; float ss = 0.f;
#pragma unroll
            for (int j = 0; j < 4; ++j) ss += v[j] * v[j];
            const float rk = __builtin_amdgcn_rsqf(sum16(ss) * (1.0f / 64.0f) + EPS);
            if (lane < 32) *(GAS v2u*)(urow + UC_SK + 64 * kh + 4 * sub) = dry ? sk[u] : (v2u){pk2(v[0] * rk * C.sgkv[0], v[1] * rk * C.sgkv[1]), pk2(v[2] * rk * C.sgkv[2], v[3] * rk * C.sgkv[3])};
        }
    }
}
template <int R> __device__ __forceinline__ void t3_run(const Frame& F, const T3Const& C, int t0) {
    const int lane = F.lane, c0 = 4 * lane, pg = lane >> 4, pw = 2 << pg;
    const bf16* U = (const bf16*)(F.ws + WS_U); bf16* Y = (bf16*)(F.ws + WS_Y);
    const int s0 = t0 & (SEQ - 1);
    const bf16* base = U + (size_t)t0 * UW + c0;
    v2u pl[R + 15], cc[R + 2], chh[R + 2], cbg[R];
#pragma unroll
    for (int i = 0; i < R + 15; ++i) { const int off = i - 15; const int o2 = (off < -s0) ? -s0 : off; pl[i] = *(const GAS v2u*)(base + (ptrdiff_t)o2 * UW + UC_POOL); }
#pragma unroll
    for (int i = 0; i < R + 2; ++i) { const int off = i - 2; const int o2 = (off < -s0) ? -s0 : off; cc[i] = *(const GAS v2u*)(base + (ptrdiff_t)o2 * UW + UC_CC); chh[i] = *(const GAS v2u*)(base + (ptrdiff_t)o2 * UW + UC_CH); }
#pragma unroll
    for (int u = 0; u < R; ++u) cbg[u] = *(const GAS v2u*)(base + (size_t)u * UW + UC_CB);
#pragma unroll
    for (int u = 0; u < R; ++u) { const int t = t0 + u, s = s0 + u;
        {
            const int cnt = (s + 1 < pw) ? (s + 1) : pw;
            float a[4] = {0.f, 0.f, 0.f, 0.f};
#pragma unroll
            for (int tau = 0; tau < 16; ++tau) { const float m = (tau < cnt) ? 1.0f : 0.0f; const v2u w = pl[15 + u - tau];
                a[0] += m * bflo(w.x); a[1] += m * bfhi(w.x); a[2] += m * bflo(w.y); a[3] += m * bfhi(w.y); }
            const v2u w0 = pl[15 + u]; const float u0[4] = {bflo(w0.x), bfhi(w0.x), bflo(w0.y), bfhi(w0.y)};
            const float ic = 1.0f / (float)cnt; float ss = 0.f;
#pragma unroll
            for (int j = 0; j < 4; ++j) { a[j] = a[j] * ic - u0[j]; ss += a[j] * a[j]; }
            const float r = __builtin_amdgcn_rsqf(wave_sum(ss) * (1.0f / 256.0f) + EPS);
            *(GAS v2u*)(Y + (size_t)t * 1024 + 512 + c0) = (v2u){pk2(a[0] * r, a[1] * r), pk2(a[2] * r, a[3] * r)};
        }
        {
            float z[3][4];
#pragma unroll
            for (int tau = 0; tau < 3; ++tau) { const float m = (s - tau >= 0) ? 1.0f : 0.0f; const v2u wc = cc[u + 2 - tau], wh = chh[u + 2 - tau];
                z[tau][0] = m * bflo(wc.x) * bflo(wh.x); z[tau][1] = m * bfhi(wc.x) * bfhi(wh.x); z[tau][2] = m * bflo(wc.y) * bflo(wh.y); z[tau][3] = m * bfhi(wc.y) * bfhi(wh.y); }
            const v2u wb = cbg[u]; const float bg[4] = {bflo(wb.x), bfhi(wb.x), bflo(wb.y), bfhi(wb.y)};
            float y[4]; float ss = 0.f;
#pragma unroll
            for (int j = 0; j < 4; ++j) { y[j] = bg[j] * (C.cwv[0][j] * z[2][j] + C.cwv[1][j] * z[1][j] + C.cwv[2][j] * z[0][j] + C.cbv[j]); ss += y[j] * y[j]; }
            const float r = __builtin_amdgcn_rsqf(wave_sum(ss) * (1.0f / 256.0f) + EPS);
            *(GAS v2u*)(Y + (size_t)t * 1024 + 768 + c0) = (v2u){pk2(y[0] * r, y[1] * r), pk2(y[2] * r, y[3] * r)};
        }
    }
}
__device__ __forceinline__ void t3_pass(const Frame& F, int l, bool dry) {
    const int lane = F.lane, sub = lane & 15, c0 = 4 * lane;
    const float* gq = (const float*)ARGP(9) + l * 96; const float* gk = (const float*)ARGP(10) + l * 96;
    const float* sgq = (const float*)ARGP(13) + l * 64; const float* sgk = (const float*)ARGP(14) + l * 64;
    const float* cw = (const float*)ARGP(16) + l * 3 * 256; const float* cb = (const float*)ARGP(17) + l * 256;
    T3Const C;
#pragma unroll
    for (int j = 0; j < 6; ++j) { C.gqv[j] = gq[sub + 16 * j]; C.gkv[j] = (j < 4) ? gk[4 * sub + j] : gk[sub + 16 * j]; }
#pragma unroll
    for (int j = 0; j < 4; ++j) { C.sgqv[j] = sgq[sub + 16 * j]; C.sgkv[j] = sgk[4 * sub + j]; }
#pragma unroll
    for (int j = 0; j < 4; ++j) { C.cwv[0][j] = cw[c0 + j]; C.cwv[1][j] = cw[256 + c0 + j]; C.cwv[2][j] = cw[512 + c0 + j]; C.cbv[j] = cb[c0 + j]; }
    C.invf = (double)exp2f(-(float)sub * (13.287712379549449f / 16.0f)) * 0.15915494309189535;
    int t = F.gw;
    for (; t + 7 * F.NGW < M; t += 8 * F.NGW) t3_k_tokens<8>(F, C, t, F.NGW, dry);
    for (; t < M; t += F.NGW) t3_k_tokens<1>(F, C, t, F.NGW, dry);
    for (int run = F.gw; run < M / 4; run += F.NGW) t3_run<4>(F, C, 4 * run);
}
template <int UNR> __device__ __forceinline__ void t5_tokens(bf16* Y, int t0, int tstride, int col) {
    v4u w[UNR];
#pragma unroll
    for (int u = 0; u < UNR; ++u) w[u] = *(const GAS v4u*)(Y + (size_t)(t0 + u * tstride) * 1024 + col);
#pragma unroll
    for (int u = 0; u < UNR; ++u) {
        float v[8] = {bflo(w[u].x), bfhi(w[u].x), bflo(w[u].y), bfhi(w[u].y), bflo(w[u].z), bfhi(w[u].z), bflo(w[u].w), bfhi(w[u].w)}; float ss = 0.f;
#pragma unroll
        for (int j = 0; j < 8; ++j) ss += v[j] * v[j];
        const float r = __builtin_amdgcn_rsqf(sum32(ss) * (1.0f / 256.0f) + EPS);
        *(GAS v4u*)(Y + (size_t)(t0 + u * tstride) * 1024 + col) = (v4u){pk2(v[0] * r, v[1] * r), pk2(v[2] * r, v[3] * r), pk2(v[4] * r, v[5] * r), pk2(v[6] * r, v[7] * r)}; }
}
__device__ __forceinline__ void t5_pass(const Frame& F) {
    bf16* Y = (bf16*)(F.ws + WS_Y); const int lane = F.lane; const int col = (lane < 32) ? 8 * lane : 512 + 8 * (lane - 32);
    int t = F.gw;
    for (; t + 7 * F.NGW < M; t += 8 * F.NGW) t5_tokens<8>(Y, t, F.NGW, col);
    for (; t < M; t += F.NGW) t5_tokens<1>(Y, t, F.NGW, col);
}
__device__ __forceinline__ void kx_norm_pass(const Frame& F) {
    bf16* KV = (bf16*)(F.ws + WS_KVX); const int lane = F.lane, h = lane >> 4, sub = lane & 15;
    for (int it = F.gw; it < MM * NL; it += F.NGW) { const int row = it >> 1, l = it & 1; const float* g = (const float*)ARGP(25) + l * 64;
        bf16* p = KV + (size_t)row * 1024 + 512 * l + 64 * h; float v[4]; float ss = 0.f;
#pragma unroll
        for (int j = 0; j < 4; ++j) { v[j] = bf2f(p[sub + 16 * j]); ss += v[j] * v[j]; }
        const float r = __builtin_amdgcn_rsqf(sum16(ss) * (1.0f / 64.0f) + EPS);
#pragma unroll
        for (int j = 0; j < 4; ++j) p[sub + 16 * j] = (bf16)f2bf(v[j] * r * g[sub + 16 * j]); }
}

__device__ __forceinline__ void route_pass(const Frame& F, int l) {
    int* EID = (int*)(F.ws + WS_EID); int* RANK = (int*)(F.ws + WS_SLOT); int* CNT = (int*)(F.ws + WS_CTL) + CW_CNT + 2048 * l;
    int* TOKR = (int*)(F.ws + WS_TOKR); float* RSR = (float*)(F.ws + WS_RSR); float* WR = (float*)(F.ws + WS_WR);
    const float* STX = (const float*)(F.ws + WS_STX); const bf16* XB = (const bf16*)(F.ws + WS_XB);
    const bf16* BR = (const bf16*)(F.ws + WS_W + (size_t)l * 57 * MiB + WL_R);
    const float* bg = (const float*)ARGP(29) + l * 4; const float* be = (const float*)ARGP(31) + l * 32;
    LAS int* lh = (LAS int*)(F.lds + RING_OFF);
    LAS float* llog = (LAS float*)(F.lds + RING_OFF + 1024);
    LAS int* lbase = lh + 32;
    const int lane = F.lane, fr = lane & 15, fq = lane >> 4;
    for (int ch = F.bx; ch < M / 128; ch += F.G) {
        if (F.tid < 32) lh[F.tid] = 0;
        float rn_pre = 0.f;
        if (F.tid < 128) { const int t = ch * 128 + F.tid; float ss = 0.f;
#pragma unroll
            for (int i = 0; i < 16; i += 4) { const f32x4 p4 = *(const GAS f32x4*)(STX + (size_t)t * 16 + i); ss += (p4[0] + p4[1]) + (p4[2] + p4[3]); }
            rn_pre = __builtin_amdgcn_rsqf(ss * (1.0f / D) + EPS); }
        {
            const bf16* ap = XB + (size_t)(ch * 128 + 16 * F.wave + fr) * D + 8 * fq;
            LAS unsigned char* lb = (LAS unsigned char*)F.lds + RING_OFF + 32768;
            bf16x8 a[32];
#pragma unroll
            for (int i = 0; i < 32; ++i) a[i] = *(const GAS bf16x8*)(ap + 32 * i);
            f32x4 acc0 = {0.f, 0.f, 0.f, 0.f}, acc1 = acc0, acc2 = acc0;
#pragma unroll
            for (int q = 0; q < 4; ++q) {
                if (q) __syncthreads();
#pragma unroll
                for (int j = 0; j < 3; ++j) { const int p = F.tid + NTHR * j, row = p >> 5, c = p & 31; *(LAS v4u*)(lb + row * 528 + c * 16) = *(const GAS v4u*)(BR + (size_t)row * D + 256 * q + 8 * c); }
                __syncthreads();
#pragma unroll
                for (int i = 0; i < 8; ++i) { const LAS unsigned char* bq = lb + fr * 528 + 64 * i + 16 * fq;
                    const bf16x8 b0 = *(const LAS bf16x8*)bq, b1 = *(const LAS bf16x8*)(bq + 16 * 528), b2 = *(const LAS bf16x8*)(bq + 32 * 528);
                    acc0 = __builtin_amdgcn_mfma_f32_16x16x32_bf16(a[8 * q + i], b0, acc0, 0, 0, 0); acc1 = __builtin_amdgcn_mfma_f32_16x16x32_bf16(a[8 * q + i], b1, acc1, 0, 0, 0); acc2 = __builtin_amdgcn_mfma_f32_16x16x32_bf16(a[8 * q + i], b2, acc2, 0, 0, 0); } }
#pragma unroll
            for (int r = 0; r < 4; ++r) { LAS float* row = llog + (16 * F.wave + 4 * fq + r) * 52; row[fr] = acc0[r]; row[16 + fr] = acc1[r]; row[32 + fr] = acc2[r]; } }
        __syncthreads();
        if (F.wave >= 2 && ch == F.bx) prep_experts<1>(F, l, F.bx * 6 + (F.wave - 2), F.G * 6);
        int re1 = 0, re2 = 0, rr1 = 0, rr2 = 0; float rw1 = 0.f, rw2 = 0.f, rrn = 0.f;
        if (F.tid < 128) { const int t = ch * 128 + F.tid; const LAS float* lr = llog + F.tid * 52;
            const float rn = rn_pre;
            float g[4]; int gi = 0;
#pragma unroll
            for (int j = 0; j < 4; ++j) g[j] = lr[j] * rn + bg[j];
#pragma unroll
            for (int j = 1; j < 4; ++j) if (g[j] > g[gi]) gi = j;
            float gs = 0.f;
#pragma unroll
            for (int j = 0; j < 4; ++j) gs += __expf(g[j] - g[gi]);
            const float gw = 1.0f / gs;
            float e[8];
#pragma unroll
            for (int j = 0; j < 8; ++j) e[j] = lr[4 + 8 * gi + j] * rn + be[8 * gi + j];
            int i1 = 0;
#pragma unroll
            for (int j = 1; j < 8; ++j) if (e[j] > e[i1]) i1 = j;
            int i2 = (i1 == 0) ? 1 : 0;
#pragma unroll
            for (int j = 0; j < 8; ++j) if (j != i1 && e[j] > e[i2]) i2 = j;
            const float d = __expf(e[i2] - e[i1]);
            const float w1 = gw / (1.0f + d), w2 = gw * d / (1.0f + d);
            const int e1 = 8 * gi + i1, e2 = 8 * gi + i2;
            EID[2 * t] = e1; EID[2 * t + 1] = e2;
            re1 = e1; re2 = e2; rw1 = w1; rw2 = w2; rrn = rn;
            rr1 = atomicAdd((int*)&lh[e1], 1); rr2 = atomicAdd((int*)&lh[e2], 1); }
        __syncthreads();
        if (F.tid < 32) lbase[F.tid] = (lh[F.tid] > 0) ? atomicAdd(&CNT[64 * F.tid], lh[F.tid]) : 0;
        __syncthreads();
        if (F.tid < 128) { const int t = ch * 128 + F.tid; const int k1 = lbase[re1] + rr1, k2 = lbase[re2] + rr2;
            TOKR[(size_t)re1 * ECAP + k1] = t; RSR[(size_t)re1 * ECAP + k1] = rrn; WR[(size_t)re1 * ECAP + k1] = rw1; RANK[2 * t] = k1;
            TOKR[(size_t)re2 * ECAP + k2] = t; RSR[(size_t)re2 * ECAP + k2] = rrn; WR[(size_t)re2 * ECAP + k2] = rw2; RANK[2 * t + 1] = k2; }
        __syncthreads();
    }
}
__device__ __forceinline__ int shfl_up_l(int v, int o, int lane_l) { return __builtin_amdgcn_ds_bpermute(((lane_l - o) & 63) << 2, v); }
__device__ __forceinline__ int moe_tables(const Frame& F, int l, LAS int* cnt, LAS int* pblk, LAS int* bexp) {
    const int* CNT = (const int*)(F.ws + WS_CTL) + CW_CNT + 2048 * l;
    if (F.tid < 64) { const int e = F.tid & 31; const int c = CNT[64 * e]; const int nb = (F.tid < 32) ? ((c + 255) >> 8) : 0; int inc = nb;
        int ll = F.tid; asm volatile("" : "+v"(ll));
#pragma unroll
        for (int o = 1; o < 32; o <<= 1) { const int v = shfl_up_l(inc, o, ll); if ((ll & 31) >= o) inc += v; }
        if (F.tid < 32) { cnt[e] = c; const int pb = inc - nb; pblk[e] = pb; for (int j = 0; j < nb; ++j) bexp[pb + j] = e; if (e == 31) pblk[32] = inc; } }
    __syncthreads();
    return pblk[32];
}
template <int UNR> __device__ __forceinline__ void combine_tokens(const Frame& F, int l, int t0, int tstride, float ysc, int pstart) {
    typedef float f32x2 __attribute__((ext_vector_type(2)));
    const int* RANK = (const int*)(F.ws + WS_SLOT); const int* EID = (const int*)(F.ws + WS_EID); const unsigned char* YB = (const unsigned char*)(F.ws + WS_YB); bf16* XB = (bf16*)(F.ws + WS_XB); float* STX = (float*)(F.ws + WS_STX);
    int s0[UNR], s1[UNR];
#pragma unroll
    for (int u = 0; u < UNR; ++u) { const int t = t0 + u * tstride;
        s0[u] = __shfl(pstart, EID[2 * t]) + RANK[2 * t]; s1[u] = __shfl(pstart, EID[2 * t + 1]) + RANK[2 * t + 1]; }
    v4u xv[UNR][2], a[UNR], b[UNR];
#pragma unroll
    for (int u = 0; u < UNR; ++u) { const int t = t0 + u * tstride;
        const GAS v4u* xr = (const GAS v4u*)(XB + (size_t)t * D) + 2 * F.lane;
        xv[u][0] = xr[0]; xv[u][1] = xr[1];
        a[u] = *((const GAS v4u*)(YB + (size_t)s0[u] * D) + F.lane); b[u] = *((const GAS v4u*)(YB + (size_t)s1[u] * D) + F.lane); }
#pragma unroll
    for (int u = 0; u < UNR; ++u) { const int t = t0 + u * tstride; float ss = 0.f; float x[16];
#pragma unroll
        for (int q = 0; q < 4; ++q) {
            const f32x2 a01 = __builtin_amdgcn_cvt_pk_f32_fp8((int)a[u][q], false), a23 = __builtin_amdgcn_cvt_pk_f32_fp8((int)a[u][q], true);
            const f32x2 b01 = __builtin_amdgcn_cvt_pk_f32_fp8((int)b[u][q], false), b23 = __builtin_amdgcn_cvt_pk_f32_fp8((int)b[u][q], true);
            const unsigned xw0 = xv[u][q >> 1][2 * (q & 1)], xw1 = xv[u][q >> 1][2 * (q & 1) + 1];
            x[4 * q] = bflo(xw0) + ysc * (a01.x + b01.x); x[4 * q + 1] = bfhi(xw0) + ysc * (a01.y + b01.y);
            x[4 * q + 2] = bflo(xw1) + ysc * (a23.x + b23.x); x[4 * q + 3] = bfhi(xw1) + ysc * (a23.y + b23.y); }
#pragma unroll
        for (int q = 0; q < 16; ++q) ss += x[q] * x[q];
        if (l == 0) { GAS v4u* xo = (GAS v4u*)(XB + (size_t)t * D) + 2 * F.lane;
            xo[0] = (v4u){pk2(x[0], x[1]), pk2(x[2], x[3]), pk2(x[4], x[5]), pk2(x[6], x[7])}; xo[1] = (v4u){pk2(x[8], x[9]), pk2(x[10], x[11]), pk2(x[12], x[13]), pk2(x[14], x[15])};
            ss = wave_sum(ss); if (F.lane < 16) STX[(size_t)t * 16 + F.lane] = (F.lane == 0) ? ss : 0.f; }
        else { GAS f32x4* o = (GAS f32x4*)(F.X + (size_t)t * D) + 4 * F.lane;
#pragma unroll
            for (int q = 0; q < 4; ++q) o[q] = (f32x4){x[4 * q], x[4 * q + 1], x[4 * q + 2], x[4 * q + 3]}; } }
}
__device__ __forceinline__ void combine_pass(const Frame& F, int l, float ysc) {
    int pstart;
    { const int* CNT = (const int*)(F.ws + WS_CTL) + CW_CNT + 2048 * l; const int nb = (F.lane < 32) ? ((CNT[64 * (F.lane & 31)] + 255) >> 8) : 0; int inc = nb;
      int ll = F.lane; asm volatile("" : "+v"(ll));
#pragma unroll
      for (int o = 1; o < 32; o <<= 1) { const int v = shfl_up_l(inc, o, ll); if ((ll & 31) >= o) inc += v; }
      pstart = (inc - nb) << 8; }
    int t = F.gw;
    for (; t + 3 * F.NGW < M; t += 4 * F.NGW) combine_tokens<4>(F, l, t, F.NGW, ysc, pstart);
    for (; t < M; t += F.NGW) combine_tokens<1>(F, l, t, F.NGW, ysc, pstart);
}

__device__ __forceinline__ Frame mkframe(unsigned char* lds_raw) {
    Frame F;
    F.lds = (LAS unsigned char*)lds_raw;
    F.MISC = (volatile LAS unsigned*)(F.lds + MISC_OFF);
    F.tid = tid_now(); F.lane = F.tid & 63; F.wave = __builtin_amdgcn_readfirstlane(F.tid >> 6);
    int bx = blockIdx.x; asm volatile("" : "+s"(bx));
    F.bx = bx; F.G = kernarg_G(); F.vcu = (F.G % 8 == 0) ? (bx % 8) * (F.G / 8) + bx / 8 : bx;
    F.gw = F.vcu * NWAVES + F.wave; F.NGW = F.G * NWAVES;
    F.ws = ARG_WS; F.X = ARG_OUT;
    return F;
}
__device__ __forceinline__ void grid_bar(unsigned char* lds_raw) {
    XcdBarrier b; b.bar = (unsigned*)(ARG_WS + WS_CTL) + CW_BAR; b.x = xb_xcc_id(); b.st = (volatile LAS unsigned*)((LAS unsigned char*)lds_raw + MISC_OFF) + 8;
    xcd_barrier(b);
}
#define GRID_BAR() do { grid_bar(lds_raw); if ((PROBE_MASK >> 20) & 1) grid_bar(lds_raw); } while (0)
#define WSP(T, off) ((T*)(F.ws + (off)))
#define WLP(off) ((const bf16*)(F.ws + WS_W + (size_t)l * 57 * MiB + (off)))

#define ATTN_UNIT(DQK, MASK, PUB, NR, LDS, W) do { if (NR) attn_unit<DQK, MASK, true, PUB, true>(LDS, W); else attn_unit<DQK, MASK, true, PUB, false>(LDS, W); } while (0)
template <int l> __device__ __forceinline__ void layer_body(unsigned char* lds_raw) {
        REP(1)
        {   const Frame F = mkframe(lds_raw);
            pg8::Gemm g{WSP(bf16, WS_XB), WLP(WL_IN), M, UW, D, D, D}; pg8::StaticOrder S; S.init(M, UW, F.G, F.bx);
            pg8::EpiU E{WSP(bf16, WS_U), UW, WSP(float, WS_STQ), WSP(float, WS_STKV), WSP(float, WS_STX), EPS, M};
            pg8::gemm_phase<pg8::EpiU, pg8::StaticOrder, PG8_ALIGN, PG8_SP2>(F.lds + RING_OFF, g, S, E); }
        if (l == 0) {
            const Frame F = mkframe(lds_raw);
            pg8::Gemm g{WSP(bf16, WS_MN), WSP(bf16, WS_XKV), MM, 1024, D, D, D}; pg8::StaticOrder S; S.init(MM, 1024, F.G, F.bx);
            pg8::EpiPlainBf16 E{WSP(bf16, WS_KVX), 1024};
            pg8::gemm_phase<pg8::EpiPlainBf16, pg8::StaticOrder, PG8_ALIGN, PG8_SP2>(F.lds + RING_OFF, g, S, E); }
        GRID_BAR();
        REP(2)
        {   const Frame F = mkframe(lds_raw);
            pg8::Gemm g{WSP(bf16, WS_U), WLP(WL_UP), M, 1024, 384, UW, 384}; pg8::StaticOrder S; S.init(M, 1024, F.G, F.bx);
            pg8::EpiScaleBf16 E{WSP(bf16, WS_QKV), 1024, WSP(float, WS_STQ), WSP(float, WS_STKV), 2, 4, 4, 1.0f / 256.0f, 1.0f / 128.0f, EPS, M};
            pg8::gemm_phase<pg8::EpiScaleBf16, pg8::StaticOrder, PG8_ALIGN, PG8_SP2>(F.lds + RING_OFF, g, S, E); }
        GRID_BAR();
        REP(3)
        {   const Frame F = mkframe(lds_raw);
            t3_pass(F, l, rep_ != 0);
            if (l == 0 && rep_ == 0) kx_norm_pass(F); }
        GRID_BAR();
        {   const Frame F = mkframe(lds_raw);
            bf16* QKV = WSP(bf16, WS_QKV); bf16* Y = WSP(bf16, WS_Y); bf16* U = WSP(bf16, WS_U);
            const float* mgq = (const float*)ARGP(9) + l * 96; const int* positions = (const int*)ARGP(2); const float* sgq = (const float*)ARGP(13) + l * 64;
            const float mla_kb = wave_absmax((const float*)ARGP(10) + l * 96, 96, F.lane) * 9.9f, swa_kb = wave_absmax((const float*)ARGP(14) + l * 64, 64, F.lane) * 8.08f;
            const float* sinks = (const float*)ARGP(15) + l * 4;
            const bool nr_mla = (wave_absmax(mgq, 96, F.lane) * 9.9f * (0.10206207261596575f * LOG2E) * mla_kb <= 64.0f);
            const bool nr_swa = (wave_absmax(sgq, 64, F.lane) * 8.08f * (0.125f * LOG2E) * swa_kb <= 64.0f) && (wave_absmax(sinks, 4, F.lane) * LOG2E <= 64.0f);
            REP(4)
            for (int j = F.vcu; j < 512; j += F.G) {
                const int bh = (j & 255) >> 3, qb = (j < 256) ? (j & 7) : 15 - (j & 7), b = bh >> 2, h = bh & 3;
                const size_t row0 = (size_t)b * SEQ;
                AttnWave W;
                W.Q = QKV + (row0 + 256 * qb + 32 * F.wave) * 1024 + 96 * h; W.ldq = 1024;
                W.O = Y + (row0 + 256 * qb + 32 * F.wave) * 1024 + 64 * h; W.ldo = 1024;
                W.K0 = QKV + row0 * 1024 + QC_KV + 128 * h; W.K1 = QKV + row0 * 1024 + QC_KR + 32 * h; W.ldk = 1024;
                W.V = QKV + row0 * 1024 + QC_KV + 128 * h + 64; W.ldv = 1024;
                W.NT = 4 * (qb + 1); W.qpos0 = 256 * qb + 32 * F.wave; W.sink = -INFINITY; W.qgain = mgq; W.qscale = 0.10206207261596575f * LOG2E; W.pos = positions + row0 + 256 * qb + 32 * F.wave; W.st = WSP(float, WS_STQ) + (row0 + 256 * qb + 32 * F.wave) * 4 + h; W.kbound = mla_kb; W.oflag = nullptr;
                ATTN_UNIT(96, 1, false, nr_mla, F.lds + RING_OFF, W);
            }
            REP(16)
            for (int j = F.vcu; j < 512; j += F.G) {
                const int b = j >> 6, kvh = (j >> 5) & 1, n = j & 31, g = F.wave >> 2, h = 2 * kvh + g;
                const size_t row0 = (size_t)b * SEQ; const int kstart = (n > 0) ? 128 * (n - 1) : 0; const int qoff = 128 * n + 32 * (F.wave & 3);
                AttnWave W;
                W.Q = U + (row0 + qoff) * UW + UC_SQ + 64 * h; W.ldq = UW;
                W.O = Y + (row0 + qoff) * 1024 + 256 + 64 * h; W.ldo = 1024;
                W.K0 = U + (row0 + kstart) * UW + UC_SK + 64 * kvh; W.K1 = W.K0; W.ldk = UW;
                W.V = U + (row0 + kstart) * UW + UC_SV + 64 * kvh; W.ldv = UW;
                W.NT = (n > 0) ? 4 : 2; W.qpos0 = qoff - kstart; W.sink = sinks[h] * LOG2E; W.qgain = sgq; W.qscale = 0.125f * LOG2E; W.pos = nullptr; W.st = WSP(float, WS_STKV) + (row0 + qoff) * 4 + h; W.kbound = swa_kb; W.oflag = nullptr;
                ATTN_UNIT(64, 2, false, nr_swa, F.lds + RING_OFF, W);
            }
        }
        GRID_BAR();
        REP(6)
        {   const Frame F = mkframe(lds_raw);
            pg8::Gemm g{WSP(bf16, WS_Y), WLP(WL_MIX), M, D, D, D, D}; pg8::StaticOrder S; S.init(M, D, F.G, F.bx);
            LAS float* tbl = (LAS float*)(F.lds + RING_BYTES + 4096); const float* SA = WSP(float, WS_STQ); const float* SC = WSP(float, WS_STKV);
            for (int i = 0; i < 4; ++i) { pg8::Unit u; if (!S.next(i, u)) break;
                if (F.tid < 256) { const size_t row = (size_t)u.pm * 256 + F.tid; const f32x4 a4 = *(const GAS f32x4*)(SA + row * 4), c4 = *(const GAS f32x4*)(SC + row * 4);
                    const float ra = __builtin_amdgcn_rsqf(((a4[0] + a4[1]) + (a4[2] + a4[3])) * (1.0f / 256.0f) + EPS), rc = __builtin_amdgcn_rsqf(((c4[0] + c4[1]) + (c4[2] + c4[3])) * (1.0f / 256.0f) + EPS);
                    tbl[(i * 256 + F.tid) * 2] = ra / rc; tbl[(i * 256 + F.tid) * 2 + 1] = rc; } }
            __syncthreads();
            pg8::EpiResMix E{WSP(bf16, WS_XB), D, WSP(float, WS_STX), M, tbl};
            pg8::gemm_phase<pg8::EpiResMix, pg8::StaticOrder, PG8_ALIGN, PG8_SP2>(F.lds + RING_OFF, g, S, E); }
        GRID_BAR();
        if (kernarg_G() == 256) {
        REP(7)
        {   const Frame F = mkframe(lds_raw);
            unsigned* QF = (unsigned*)(F.ws + WS_CTL) + CW_FQ + 8192 * l; unsigned* OF = (unsigned*)(F.ws + WS_CTL) + CW_FO + 8192 * l;
            const int half = F.bx >> 7;
            pg8::StaticOrderPub S; S.init(M, 256, F.G, F.bx & 127); S.flg = QF; S.lane = F.lane;
            pg8::Unit u0; (void)S.next(0, u0); const int pm = u0.pm;
            if (half == 0) {
                pg8::Gemm g{WSP(bf16, WS_XB), WLP(WL_XQ), M, 256, D, D, D};
                pg8::EpiScaleBf16WT E{WSP(bf16, WS_QX), 256, WSP(float, WS_STX), WSP(float, WS_STX), 1, 16, 16, 1.0f / 1024.0f, 1.0f / 1024.0f, EPS, M};
                pg8::gemm_phase<pg8::EpiScaleBf16WT, pg8::StaticOrderPub, PG8_ALIGN, PG8_SP2>(F.lds + RING_OFF, g, S, E);
            } else { prep_experts<0>(F, l, (F.bx - 128) * NWAVES + F.wave, 128 * NWAVES);
                if (l == 0) {
                    prep_weights<false>(F, 1, 1, IT_GU + IT_DN, IT_O_POOL, (F.bx - 128) * NWAVES + F.wave, 128 * NWAVES);
                    prep_weights<false>(F, 1, 1, IT_O_POOL + IT_POOL, IT_O_XKV, (F.bx - 128) * NWAVES + F.wave, 128 * NWAVES);
                    prep_weights<false>(F, 1, 1, IT_O_XKV + IT_XKV, IT_LAYER, (F.bx - 128) * NWAVES + F.wave, 128 * NWAVES); } }
            {   bf16* QX = WSP(bf16, WS_QX); bf16* OX = WSP(bf16, WS_OX); bf16* KVX = WSP(bf16, WS_KVX);
                const float* xgq = (const float*)ARGP(24) + l * 64;
                const float x_kb = wave_absmax((const float*)ARGP(25) + l * 64, 64, F.lane) * 8.08f;
                const bool nr_x = (wave_absmax(xgq, 64, F.lane) * 8.08f * (0.125f * LOG2E) * x_kb <= 64.0f);
                pg8::flag_wait_wg(QF + 64 * pm, 8u);
                for (int hh = 0; hh < 2; ++hh) {
                    const int b = pm >> 4, h = 2 * half + hh, qb = pm & 15;
                    const size_t row0 = (size_t)b * SEQ + 256 * qb + 32 * F.wave;
                    AttnWave W;
                    W.Q = QX + row0 * 256 + 64 * h; W.ldq = 256; W.O = OX + row0 * 256 + 64 * h; W.ldo = 256;
                    W.K0 = KVX + (size_t)(b * MEMLEN) * 1024 + 512 * l + 64 * h; W.K1 = W.K0; W.ldk = 1024;
                    W.V = W.K0 + 256; W.ldv = 1024;
                    W.NT = 4; W.qpos0 = 0; W.sink = -INFINITY; W.qgain = xgq; W.qscale = 0.125f * LOG2E; W.pos = nullptr; W.st = nullptr; W.kbound = x_kb; W.oflag = OF + 64 * pm;
                    ATTN_UNIT(64, 0, true, nr_x, F.lds + RING_OFF, W);
                } }
            {   pg8::flag_wait_wg(OF + 64 * pm, 32u);
                pg8::Gemm g{WSP(bf16, WS_OX), WLP(WL_XO), M, D, 256, 256, 256}; pg8::PairOrder S9{pm, 2 * half};
                pg8::EpiRes E{WSP(bf16, WS_XB), D, WSP(float, WS_STX), M};
                pg8::gemm_phase<pg8::EpiRes, pg8::PairOrder, PG8_ALIGN, PG8_SP2>(F.lds + RING_OFF, g, S9, E); } }
        } else {
        REP(7)
        {   const Frame F = mkframe(lds_raw);
            pg8::Gemm g{WSP(bf16, WS_XB), WLP(WL_XQ), M, 256, D, D, D}; pg8::StaticOrder S; S.init(M, 256, F.G, F.bx);
            pg8::EpiScaleBf16 E{WSP(bf16, WS_QX), 256, WSP(float, WS_STX), WSP(float, WS_STX), 1, 16, 16, 1.0f / 1024.0f, 1.0f / 1024.0f, EPS, M};
            if (F.G == 256 && F.bx >= 128) prep_experts<0>(F, l, (F.bx - 128) * NWAVES + F.wave, 128 * NWAVES);
            else {
            pg8::gemm_phase<pg8::EpiScaleBf16, pg8::StaticOrder, PG8_ALIGN, PG8_SP2>(F.lds + RING_OFF, g, S, E);
            if (F.G != 256) prep_experts<0>(F, l, F.gw, F.NGW); } }
        GRID_BAR();
        REP(8)
        {   const Frame F = mkframe(lds_raw);
            bf16* QX = WSP(bf16, WS_QX); bf16* OX = WSP(bf16, WS_OX); bf16* KVX = WSP(bf16, WS_KVX);
            const float* xgq = (const float*)ARGP(24) + l * 64;
            const float x_kb = wave_absmax((const float*)ARGP(25) + l * 64, 64, F.lane) * 8.08f;
            const bool nr_x = (wave_absmax(xgq, 64, F.lane) * 8.08f * (0.125f * LOG2E) * x_kb <= 64.0f);
            for (int j = F.vcu; j < 512; j += F.G) {
                const int b = j >> 6, h = (j >> 4) & 3, qb = j & 15;
                const size_t row0 = (size_t)b * SEQ + 256 * qb + 32 * F.wave;
                AttnWave W;
                W.Q = QX + row0 * 256 + 64 * h; W.ldq = 256; W.O = OX + row0 * 256 + 64 * h; W.ldo = 256;
                W.K0 = KVX + (size_t)(b * MEMLEN) * 1024 + 512 * l + 64 * h; W.K1 = W.K0; W.ldk = 1024;
                W.V = W.K0 + 256; W.ldv = 1024;
                W.NT = 4; W.qpos0 = 0; W.sink = -INFINITY; W.qgain = xgq; W.qscale = 0.125f * LOG2E; W.pos = nullptr; W.st = nullptr; W.kbound = x_kb; W.oflag = nullptr;
                ATTN_UNIT(64, 0, false, nr_x, F.lds + RING_OFF, W);
            }
        }
        GRID_BAR();
        REP(9)
        {   const Frame F = mkframe(lds_raw);
            pg8::Gemm g{WSP(bf16, WS_OX), WLP(WL_XO), M, D, 256, 256, 256}; pg8::StaticOrder S; S.init(M, D, F.G, F.bx);
            pg8::EpiRes E{WSP(bf16, WS_XB), D, WSP(float, WS_STX), M};
            pg8::gemm_phase<pg8::EpiRes, pg8::StaticOrder, PG8_ALIGN, PG8_SP2>(F.lds + RING_OFF, g, S, E); }
        }
        GRID_BAR();
        REP(11)
        {   const Frame F = mkframe(lds_raw);
            route_pass(F, l); }
        GRID_BAR();
        REP(13)
        {   const Frame F = mkframe(lds_raw);
            LAS int* gidx = (LAS int*)(F.lds + RING_BYTES); LAS int* cnt = (LAS int*)(F.lds + RING_BYTES + 4096); LAS int* pblk = cnt + 32; LAS int* bexp = pblk + 40;
            const int nused = moe_tables(F, l, cnt, pblk, bexp);
            { const int* TOKR = WSP(int, WS_TOKR); const float* RSR = WSP(float, WS_RSR); const float* WR = WSP(float, WS_WR); float* RSLOT = WSP(float, WS_RSLOT); float* WSLOT = WSP(float, WS_WSLOT);
              int tk[4]; float rsv[4], wv[4];
#pragma unroll
              for (int i = 0; i < 4; ++i) { const int L = i * F.G + F.vcu; tk[i] = 0; rsv[i] = 0.f; wv[i] = 0.f;
                if (L < (nused << 1) && F.tid < 256) { const int pm = L >> 1, e = bexp[pm], rk = (pm - pblk[e]) * 256 + F.tid; const size_t q = (size_t)e * ECAP + rk;
                    if (rk < cnt[e]) { tk[i] = TOKR[q]; rsv[i] = RSR[q]; wv[i] = WR[q]; } } }
#pragma unroll
              for (int i = 0; i < 4; ++i) { const int L = i * F.G + F.vcu;
                if (L < (nused << 1) && F.tid < 256) { const int pm = L >> 1; gidx[i * 256 + F.tid] = tk[i]; RSLOT[pm * 256 + F.tid] = rsv[i]; WSLOT[pm * 256 + F.tid] = wv[i]; } } }
            __syncthreads();
            pg8::Gemm g{WSP(bf16, WS_XB), WLP(WL_GU), PSLOTS, NEXP * 512, D, D, D};
            const int RG = ((nused << 1) / F.G) * F.G;
            pg8::MoeOrder S{(const int*)bexp, RG, F.G, F.vcu, 1};
            pg8::EpiSwiglu E{WSP(bf16, WS_H), 256, WSP(float, WS_RSLOT)};
            pg8::gemm_phase<pg8::EpiSwiglu, pg8::MoeOrder, PG8_ALIGN, PG8_SP2, true>(F.lds + RING_OFF, g, S, E, gidx); }
        GRID_BAR();
        REP(14)
        {   const Frame F = mkframe(lds_raw);
            LAS int* gidx = (LAS int*)(F.lds + RING_BYTES); LAS int* cnt = (LAS int*)(F.lds + RING_BYTES + 4096); LAS int* pblk = cnt + 32; LAS int* bexp = pblk + 40;
            const int nused = (rep_ == 0) ? pblk[32] : moe_tables(F, l, cnt, pblk, bexp);
            const int RG = ((nused << 1) / F.G) * F.G, T = (nused << 1) - RG, mainblk = RG >> 1;
            unsigned* FLG = (unsigned*)(F.ws + WS_CTL) + CW_FLG + 16384 * l;
            if (F.vcu < T) {
                const int L0 = RG + F.vcu; gidx += (RG / F.G) * 256;
                pg8::Gemm gu{WSP(bf16, WS_XB), WLP(WL_GU), PSLOTS, NEXP * 512, D, D, D};
                pg8::MoeTailOrder ST{(const int*)bexp, L0, mainblk, FLG, F.lane};
                pg8::EpiSwigluWT EU{WSP(bf16, WS_H), 256, WSP(float, WS_RSLOT)};
                pg8::gemm_phase<pg8::EpiSwigluWT, pg8::MoeTailOrder, PG8_ALIGN, PG8_SP2, true>(F.lds + RING_OFF, gu, ST, EU, gidx); }
            pg8::Gemm g{WSP(bf16, WS_H), WLP(WL_DN), PSLOTS, NEXP * 1024, 256, 256, 256};
            pg8::MoeOrderY S{(const int*)bexp, nused << 2, F.G, F.vcu, T, 2, mainblk, RG, FLG, F.lane};
            pg8::EpiDown E{WSP(unsigned char, WS_YB), D, WSP(float, WS_WSLOT)};
            pg8::gemm_phase<pg8::EpiDown, pg8::MoeOrderY, PG8_ALIGN, PG8_SP2>(F.lds + RING_OFF, g, S, E); }
        GRID_BAR();
        REP(15)
        {   const Frame F = mkframe(lds_raw); combine_pass(F, l, rep_ == 0 ? 1.0f : 0.0f); }
}

__global__ void __launch_bounds__(NTHR, 2) fwd_megakernel(Args A_unused) {
    extern __shared__ __attribute__((aligned(16))) unsigned char lds_raw[];
    {
        const int tid = threadIdx.x;
        for (int u = tid; u < (LDS_BYTES - LDSCTL_OFF) / 4; u += NTHR) ((LAS unsigned*)((LAS unsigned char*)lds_raw + LDSCTL_OFF))[u] = 0u;
        __syncthreads();
        (void)xcd_barrier_post((unsigned*)(ARG_WS + WS_CTL) + CW_BAR, (volatile LAS unsigned*)((LAS unsigned char*)lds_raw + MISC_OFF) + 8);
    }
    REP(0)
    {   const Frame F = mkframe(lds_raw);
        if (kernarg_G() == 256) { prep_weights(F, 0, 1, IT_GU + IT_DN, IT_LAYER, F.gw, F.NGW); prep_weights(F, 1, 1, IT_O_POOL, IT_O_POOL + IT_POOL, F.gw, F.NGW); prep_weights<false>(F, 1, 1, IT_O_XKV, IT_O_XKV + IT_XKV, F.gw, F.NGW); }
        else prep_weights(F, 0, NL, IT_GU + IT_DN, IT_LAYER, F.gw, F.NGW);
        rows_pass<false>(F, (const float*)ARGP(0), WSP(bf16, WS_XB), WSP(float, WS_STX), M);
        rows_pass<true>(F, (const float*)ARGP(1), WSP(bf16, WS_MN), nullptr, MM);
    }
    GRID_BAR();

    layer_body<0>(lds_raw);
    GRID_BAR();
    layer_body<1>(lds_raw);
}

extern "C" void kernel_launch(void* const* d_in, const int* in_sizes, int n_in, void* d_out, int out_size, void* d_ws, size_t ws_size, hipStream_t stream) {
    static int grid = 0;
    if (grid == 0) {
        if (n_in != 35 || out_size != M * D || ws_size < WS_END) { fprintf(stderr, "kernel_launch: unexpected shapes (n_in %d, out %d, ws %zu)\n", n_in, out_size, ws_size); grid = -1; return; }
        int dev = 0, cus = 0;
        if (hipGetDevice(&dev) != hipSuccess || hipDeviceGetAttribute(&cus, hipDeviceAttributeMultiprocessorCount, dev) != hipSuccess) { grid = -1; return; }
        if (hipFuncSetAttribute((const void*)fwd_megakernel, hipFuncAttributeMaxDynamicSharedMemorySize, LDS_BYTES) != hipSuccess) { fprintf(stderr, "kernel_launch: hipFuncSetAttribute failed\n"); grid = -1; return; }
        grid = cus;
    }
    if (grid < 0) return;
    (void)hipMemsetAsync((char*)d_ws + WS_CTL, 0, CTL_ZERO_BYTES, stream);
    Args a{};
    for (int i = 0; i < 35; ++i) a.in[i] = d_in[i];
    a.out = (float*)d_out; a.ws = (unsigned char*)d_ws; a.G = grid; a.pad = 0;
    hipLaunchKernelGGL(fwd_megakernel, dim3(grid), dim3(NTHR), LDS_BYTES, stream, a);
}
```

```cpp
#include <hip/hip_runtime.h>
#include <cstdio>
#include <cstdint>
#ifndef PROBE_MASK
#define PROBE_MASK 0
#endif
#define REP(k) _Pragma("unroll 1") for (int rep_ = 0; rep_ < (((PROBE_MASK) >> (k)) & 1) + 1; ++rep_)
__device__ __forceinline__ int tid_now() { int t = threadIdx.x; asm volatile("" : "+v"(t)); return t; }
struct Args { const void* in[35]; float* out; unsigned char* ws; int G; int pad; };
__device__ __forceinline__ const void* kernarg_ptr(int i) { const char* p = (const char*)__builtin_amdgcn_kernarg_segment_ptr(); asm volatile("" : "+s"(p));
    const unsigned long long v = *(const unsigned long long*)(p + 8 * i);
    const unsigned lo = __builtin_amdgcn_readfirstlane((unsigned)v), hi = __builtin_amdgcn_readfirstlane((unsigned)(v >> 32));
    return (const void*)(const __attribute__((address_space(1))) void*)(((unsigned long long)hi << 32) | lo); }
#define ARGP(i) kernarg_ptr(i)
#define ARG_OUT ((float*)kernarg_ptr(35))
#define ARG_WS ((unsigned char*)kernarg_ptr(36))
__device__ __forceinline__ int kernarg_G() { const char* p = (const char*)__builtin_amdgcn_kernarg_segment_ptr(); asm volatile("" : "+s"(p)); return __builtin_amdgcn_readfirstlane(*(const int*)(p + 8 * 37)); }
namespace pg8 {
#define PG8_LAS __attribute__((address_space(3)))
typedef unsigned short bf16_t;
typedef short bf16x8 __attribute__((ext_vector_type(8)));
typedef float f32x4 __attribute__((ext_vector_type(4)));
typedef unsigned u32x4 __attribute__((ext_vector_type(4)));
constexpr int BM = 256, BK = 64, HALF = 128, HTB = HALF * BK * 2  , STAGE_BYTES = 8 * HTB, NXCD = 8, WGM = 8;

__host__ __device__ __forceinline__ int lds_byte(int r, int c) { const int st = (r >> 4) * 2 + (c >> 5), rr = r & 15, cc = c & 31, ob = rr * 64 + cc * 2; return st * 1024 + (ob ^ (((ob >> 9) & 1) << 5)); }
__host__ __device__ __forceinline__ void stage_rc(int b, int& R, int& C) { const int st = b / 1024, sb = b % 1024, swz = sb ^ (((sb >> 9) & 1) << 5); R = (st >> 1) * 16 + swz / 64; C = (st & 1) * 32 + (swz % 64) / 2; }
__host__ __device__ __forceinline__ int perm32(int rho) { const int n = rho >> 4, i = rho & 15; return 8 * (i >> 2) + 4 * n + (i & 3); }

struct Unit { int pm, pn; };
struct Gemm { const bf16_t* A; const bf16_t* Bt; int M, N, K, lda, ldb; };

struct StaticOrder {
    int nM, nN, nwg, G, c;
    __host__ __device__ void init(int M, int N, int G_, int c_) { nM = M / BM; nN = N / BM; nwg = nM * nN; G = G_; c = c_; }
    __device__ __forceinline__ bool next(int i, Unit& u) const {
        const long L = (long)i * G + c; if (L >= nwg) return false;
        int wgid = (int)L; { const int q = nwg / NXCD, r = nwg % NXCD, xcd = wgid % NXCD, off = wgid / NXCD; wgid = (xcd < r ? xcd * (q + 1) : r * (q + 1) + (xcd - r) * q) + off; }
        const int nig = WGM * nN, gid = wgid / nig, fm = gid * WGM, gsz = (nM - fm) < WGM ? (nM - fm) : WGM;
        u.pm = __builtin_amdgcn_readfirstlane(fm + ((wgid % nig) % gsz)); u.pn = __builtin_amdgcn_readfirstlane((wgid % nig) / gsz); return true;
    }
    __device__ __forceinline__ void a_ready(const Unit&) const {}
    __device__ __forceinline__ void done(const Unit&) const {}
};


__device__ __forceinline__ void st_wt16(const void* p, u32x4 v) { asm volatile("global_store_dwordx4 %0, %1, off sc1\n\ts_nop 2" :: "v"(p), "v"(v) : "memory"); }
__device__ __forceinline__ void flag_arrive(unsigned* f, int lane) { asm volatile("s_waitcnt vmcnt(0)" ::: "memory"); if (lane == 0) (void)__hip_atomic_fetch_add(f, 1u, __ATOMIC_RELAXED, __HIP_MEMORY_SCOPE_AGENT); }
__device__ __forceinline__ void flag_wait(unsigned* f, unsigned need, int lane) {
    if (lane == 0) { unsigned sp = 0u; while (__hip_atomic_load(f, __ATOMIC_RELAXED, __HIP_MEMORY_SCOPE_AGENT) < need) { __builtin_amdgcn_s_sleep(2); if (++sp > (1u << 22)) break; } }
    __builtin_amdgcn_fence(__ATOMIC_ACQUIRE, "agent");
}
__device__ __forceinline__ void flag_wait_wg(unsigned* f, unsigned need) {
    if (threadIdx.x == 0) { unsigned sp = 0u; while (__hip_atomic_load(f, __ATOMIC_RELAXED, __HIP_MEMORY_SCOPE_AGENT) < need) { __builtin_amdgcn_s_sleep(2); if (++sp > (1u << 22)) break; }
        __builtin_amdgcn_fence(__ATOMIC_ACQUIRE, "agent"); asm volatile("s_waitcnt vmcnt(0)" ::: "memory"); }
    __syncthreads();
}
struct StaticOrderPub : StaticOrder { unsigned* flg; int lane;
    __device__ __forceinline__ void done(const Unit& u) const { flag_arrive(&flg[64 * u.pm], lane); } };
struct PairOrder { int pm, pn0;
    __device__ __forceinline__ bool next(int i, Unit& u) const { if (i >= 2) return false; u.pm = pm; u.pn = pn0 + i; return true; }
    __device__ __forceinline__ void a_ready(const Unit&) const {}
    __device__ __forceinline__ void done(const Unit&) const {} };

__device__ __forceinline__ unsigned cvt_pk_bf16(float lo, float hi) { unsigned r; asm volatile("v_cvt_pk_bf16_f32 %0, %1, %2" : "=v"(r) : "v"(lo), "v"(hi)); return r; }
__device__ __forceinline__ float sumsq4(f32x4 v) { return (v[0] * v[0] + v[1] * v[1]) + (v[2] * v[2] + v[3] * v[3]); }
__device__ __forceinline__ u32x4 pack8(f32x4 v0, f32x4 v1) { u32x4 w; w.x = cvt_pk_bf16(v0[0], v0[1]); w.y = cvt_pk_bf16(v0[2], v0[3]); w.z = cvt_pk_bf16(v1[0], v1[1]); w.w = cvt_pk_bf16(v1[2], v1[3]); return w; }

struct EpiU {
    static constexpr bool PERM = true, AFTER_DRAIN = false, KHOOK = false;
    bf16_t* O; int ldc; float* statq; float* statkv; const float* xss; float eps; int Mrows;
    __device__ __forceinline__ void operator()(const f32x4 (&acc)[2][2][4][2], const Unit& u, int wr, int wc, int fr, int fq) const {
        const int row0 = u.pm * BM + wr * 64 + fr; const int col0 = u.pn * BM + wc * 32 + 8 * fq;
#pragma unroll
        for (int ai = 0; ai < 2; ++ai)
#pragma unroll
            for (int m = 0; m < 4; ++m) { const int row = row0 + ai * HALF + m * 16; bf16_t* rowp = O + (size_t)row * ldc + col0;
                const float r = __builtin_amdgcn_rsqf(xss[(size_t)row * 16] * (1.0f / 1024.0f) + eps);
                const f32x4 v00 = acc[ai][0][m][0] * r, v01 = acc[ai][0][m][1] * r, v10 = acc[ai][1][m][0] * r, v11 = acc[ai][1][m][1] * r;
                *(u32x4*)(rowp) = pack8(v00, v01); *(u32x4*)(rowp + HALF) = pack8(v10, v11);
                if (u.pn < 2) {
                    float s = sumsq4(v00) + sumsq4(v01);
                    if (u.pn == 0) s += sumsq4(v10) + sumsq4(v11);
                    s += __shfl_xor(s, 16); s += __shfl_xor(s, 32);
                    if (fq == 0) { float* st = (u.pn == 0) ? statq : statkv; st[(size_t)row * 4 + wc] = s; }
                } }
    }
};
struct EpiScaleBf16 {
    static constexpr bool PERM = true, AFTER_DRAIN = false, KHOOK = false;
    bf16_t* O; int ldc; const float* st0; const float* st1; int split_pn, np0, np1; float inv0, inv1, eps; int Mrows;
    __device__ __forceinline__ void operator()(const f32x4 (&acc)[2][2][4][2], const Unit& u, int wr, int wc, int fr, int fq) const {
        const int row0 = u.pm * BM + wr * 64 + fr; const int col0 = u.pn * BM + wc * 32 + 8 * fq;
        const bool first = u.pn < split_pn; const float* st = first ? st0 : st1; const int np = first ? np0 : np1; const float inv = first ? inv0 : inv1;
#pragma unroll
        for (int ai = 0; ai < 2; ++ai)
#pragma unroll
            for (int m = 0; m < 4; ++m) { const int row = row0 + ai * HALF + m * 16; float s = 0.f;
                for (int i = 0; i < np; i += 4) { const f32x4 p4 = *(const f32x4*)(st + (size_t)row * np + i); s += (p4[0] + p4[1]) + (p4[2] + p4[3]); }
                const float r = __builtin_amdgcn_rsqf(s * inv + eps);
                bf16_t* rowp = O + (size_t)row * ldc + col0;
#pragma unroll
                for (int bj = 0; bj < 2; ++bj) *(u32x4*)(rowp + bj * HALF) = pack8(acc[ai][bj][m][0] * r, acc[ai][bj][m][1] * r); }
    }
};
struct EpiScaleBf16WT {
    static constexpr bool PERM = true, AFTER_DRAIN = false, KHOOK = false;
    bf16_t* O; int ldc; const float* st0; const float* st1; int split_pn, np0, np1; float inv0, inv1, eps; int Mrows;
    __device__ __forceinline__ void operator()(const f32x4 (&acc)[2][2][4][2], const Unit& u, int wr, int wc, int fr, int fq) const {
        const int row0 = u.pm * BM + wr * 64 + fr; const int col0 = u.pn * BM + wc * 32 + 8 * fq;
        const bool first = u.pn < split_pn; const float* st = first ? st0 : st1; const int np = first ? np0 : np1; const float inv = first ? inv0 : inv1;
#pragma unroll
        for (int ai = 0; ai < 2; ++ai)
#pragma unroll
            for (int m = 0; m < 4; ++m) { const int row = row0 + ai * HALF + m * 16; float s = 0.f;
                for (int i = 0; i < np; i += 4) { const f32x4 p4 = *(const f32x4*)(st + (size_t)row * np + i); s += (p4[0] + p4[1]) + (p4[2] + p4[3]); }
                const float r = __builtin_amdgcn_rsqf(s * inv + eps);
                bf16_t* rowp = O + (size_t)row * ldc + col0;
#pragma unroll
                for (int bj = 0; bj < 2; ++bj) st_wt16(rowp + bj * HALF, pack8(acc[ai][bj][m][0] * r, acc[ai][bj][m][1] * r)); }
    }
};
struct EpiRes {
    static constexpr bool PERM = true, AFTER_DRAIN = false, KHOOK = false;
    bf16_t* XB; int ldc; float* stat; int Mrows;
    __device__ __forceinline__ void operator()(const f32x4 (&acc)[2][2][4][2], const Unit& u, int wr, int wc, int fr, int fq) const {
        int pm_ = u.pm, pn_ = u.pn; asm volatile("" : "+s"(pm_), "+s"(pn_));
        const int row0 = pm_ * BM + wr * 64 + fr; const int col0 = pn_ * BM + wc * 32 + 8 * fq;
        u32x4 b[2][4][2];
#pragma unroll
        for (int ai = 0; ai < 2; ++ai)
#pragma unroll
            for (int m = 0; m < 4; ++m)
#pragma unroll
                for (int bj = 0; bj < 2; ++bj) b[ai][m][bj] = *(const u32x4*)(XB + (size_t)(row0 + ai * HALF + m * 16) * ldc + col0 + bj * HALF);
#pragma unroll
        for (int ai = 0; ai < 2; ++ai)
#pragma unroll
            for (int m = 0; m < 4; ++m) { const int row = row0 + ai * HALF + m * 16; const size_t off = (size_t)row * ldc + col0; float s = 0.f;
#pragma unroll
                for (int bj = 0; bj < 2; ++bj) { const u32x4 bb = b[ai][m][bj];
                    f32x4 v0 = acc[ai][bj][m][0], v1 = acc[ai][bj][m][1];
                    v0[0] += __builtin_bit_cast(float, bb.x << 16); v0[1] += __builtin_bit_cast(float, bb.x & 0xffff0000u); v0[2] += __builtin_bit_cast(float, bb.y << 16); v0[3] += __builtin_bit_cast(float, bb.y & 0xffff0000u);
                    v1[0] += __builtin_bit_cast(float, bb.z << 16); v1[1] += __builtin_bit_cast(float, bb.z & 0xffff0000u); v1[2] += __builtin_bit_cast(float, bb.w << 16); v1[3] += __builtin_bit_cast(float, bb.w & 0xffff0000u);
                    *(u32x4*)(XB + off + bj * HALF) = pack8(v0, v1);
                    s += sumsq4(v0) + sumsq4(v1); }
                s += __shfl_xor(s, 16); s += __shfl_xor(s, 32);
                if (fq == 0) stat[(size_t)row * 16 + u.pn * 4 + wc] = s; }
    }
};
struct EpiResMix {
    static constexpr bool PERM = true, AFTER_DRAIN = false, KHOOK = true;
    bf16_t* XB; int ldc; float* stat; int Mrows; const PG8_LAS float* tbl;
    __device__ __forceinline__ void khook(f32x4 (&acc)[2][2][4][2], int t, int ui, int wr, int fr) const {
        if (t != 4 && t != 8) return;
        const int sel = (t == 8) ? 1 : 0;
#pragma unroll
        for (int ai = 0; ai < 2; ++ai)
#pragma unroll
            for (int m = 0; m < 4; ++m) { const float sc = tbl[(ui * 256 + ai * HALF + wr * 64 + m * 16 + fr) * 2 + sel];
#pragma unroll
                for (int bj = 0; bj < 2; ++bj)
#pragma unroll
                    for (int n = 0; n < 2; ++n) acc[ai][bj][m][n] *= sc; }
    }
    __device__ __forceinline__ void operator()(const f32x4 (&acc)[2][2][4][2], const Unit& u, int wr, int wc, int fr, int fq) const {
        const int row0 = u.pm * BM + wr * 64 + fr; const int col0 = u.pn * BM + wc * 32 + 8 * fq;
        u32x4 b[2][4][2];
#pragma unroll
        for (int ai = 0; ai < 2; ++ai)
#pragma unroll
            for (int m = 0; m < 4; ++m)
#pragma unroll
                for (int bj = 0; bj < 2; ++bj) b[ai][m][bj] = *(const u32x4*)(XB + (size_t)(row0 + ai * HALF + m * 16) * ldc + col0 + bj * HALF);
#pragma unroll
        for (int ai = 0; ai < 2; ++ai)
#pragma unroll
            for (int m = 0; m < 4; ++m) { const int row = row0 + ai * HALF + m * 16; const size_t off = (size_t)row * ldc + col0; float s = 0.f;
#pragma unroll
                for (int bj = 0; bj < 2; ++bj) { const u32x4 bb = b[ai][m][bj];
                    f32x4 v0 = acc[ai][bj][m][0], v1 = acc[ai][bj][m][1];
                    v0[0] += __builtin_bit_cast(float, bb.x << 16); v0[1] += __builtin_bit_cast(float, bb.x & 0xffff0000u); v0[2] += __builtin_bit_cast(float, bb.y << 16); v0[3] += __builtin_bit_cast(float, bb.y & 0xffff0000u);
                    v1[0] += __builtin_bit_cast(float, bb.z << 16); v1[1] += __builtin_bit_cast(float, bb.z & 0xffff0000u); v1[2] += __builtin_bit_cast(float, bb.w << 16); v1[3] += __builtin_bit_cast(float, bb.w & 0xffff0000u);
                    *(u32x4*)(XB + off + bj * HALF) = pack8(v0, v1);
                    s += sumsq4(v0) + sumsq4(v1); }
                s += __shfl_xor(s, 16); s += __shfl_xor(s, 32);
                if (fq == 0) stat[(size_t)row * 16 + u.pn * 4 + wc] = s; }
    }
};
struct EpiRouter {
    static constexpr bool PERM = false, AFTER_DRAIN = false, KHOOK = false;
    float* L; const float* st; float eps; int Mrows;
    __device__ __forceinline__ void operator()(const f32x4 (&acc)[2][2][4][2], const Unit& u, int wr, int wc, int fr, int fq) const {
        if (wc >= 2) return;
        const int row0 = u.pm * BM + wr * 64 + fr; const int col0 = wc * 32 + 4 * fq;
#pragma unroll
        for (int ai = 0; ai < 2; ++ai)
#pragma unroll
            for (int m = 0; m < 4; ++m) { const int row = row0 + ai * HALF + m * 16; float s = 0.f;
#pragma unroll
                for (int i = 0; i < 16; i += 4) { const f32x4 p4 = *(const f32x4*)(st + (size_t)row * 16 + i); s += (p4[0] + p4[1]) + (p4[2] + p4[3]); }
                const float r = __builtin_amdgcn_rsqf(s * (1.0f / 1024.0f) + eps);
#pragma unroll
                for (int n = 0; n < 2; ++n) *(f32x4*)(L + (size_t)row * 64 + col0 + 16 * n) = acc[ai][0][m][n] * r; }
    }
};
__device__ __forceinline__ float silu_mul(float g, float u) { return g * u * __builtin_amdgcn_rcpf(1.0f + __builtin_amdgcn_exp2f(-1.4426950408889634f * g)); }
struct EpiSwiglu {
    static constexpr bool PERM = true, AFTER_DRAIN = false, KHOOK = false;
    bf16_t* H; int ldc; const float* rs;
    __device__ __forceinline__ void operator()(const f32x4 (&acc)[2][2][4][2], const Unit& u, int wr, int wc, int fr, int fq) const {
        const int row0 = u.pm * BM + wr * 64 + fr; const int col0 = (u.pn & 1) * HALF + wc * 32 + 8 * fq;
#pragma unroll
        for (int ai = 0; ai < 2; ++ai)
#pragma unroll
            for (int m = 0; m < 4; ++m) { const int row = row0 + ai * HALF + m * 16; f32x4 h0, h1; const float r = rs[row];
#pragma unroll
                for (int j = 0; j < 4; ++j) { h0[j] = silu_mul(acc[ai][0][m][0][j] * r, acc[ai][1][m][0][j] * r); h1[j] = silu_mul(acc[ai][0][m][1][j] * r, acc[ai][1][m][1][j] * r); }
                *(u32x4*)(H + (size_t)row * ldc + col0) = pack8(h0, h1); }
    }
};
struct EpiSwigluWT {
    static constexpr bool PERM = true, AFTER_DRAIN = false, KHOOK = false;
    bf16_t* H; int ldc; const float* rs;
    __device__ __forceinline__ void operator()(const f32x4 (&acc)[2][2][4][2], const Unit& u, int wr, int wc, int fr, int fq) const {
        const int row0 = u.pm * BM + wr * 64 + fr; const int col0 = (u.pn & 1) * HALF + wc * 32 + 8 * fq;
#pragma unroll
        for (int ai = 0; ai < 2; ++ai)
#pragma unroll
            for (int m = 0; m < 4; ++m) { const int row = row0 + ai * HALF + m * 16; f32x4 h0, h1; const float r = rs[row];
#pragma unroll
                for (int j = 0; j < 4; ++j) { h0[j] = silu_mul(acc[ai][0][m][0][j] * r, acc[ai][1][m][0][j] * r); h1[j] = silu_mul(acc[ai][0][m][1][j] * r, acc[ai][1][m][1][j] * r); }
                const u32x4 hv = pack8(h0, h1); const bf16_t* hp = H + (size_t)row * ldc + col0; asm volatile("global_store_dwordx4 %0, %1, off sc1\n\ts_nop 2" :: "v"(hp), "v"(hv) : "memory"); }
    }
};
struct EpiDown {
    static constexpr bool PERM = true, AFTER_DRAIN = false, KHOOK = false;
    unsigned char* Y; int ldc; const float* w;
    __device__ __forceinline__ void operator()(const f32x4 (&acc)[2][2][4][2], const Unit& u, int wr, int wc, int fr, int fq) const {
        typedef unsigned u32x2 __attribute__((ext_vector_type(2)));
        const int row0 = u.pm * BM + wr * 64 + fr; const int col0 = (u.pn & 3) * BM + wc * 32 + 8 * fq;
#pragma unroll
        for (int ai = 0; ai < 2; ++ai)
#pragma unroll
            for (int m = 0; m < 4; ++m) { const int row = row0 + ai * HALF + m * 16; const float r = w[row];
                unsigned char* rowp = Y + (size_t)row * ldc + col0;
#pragma unroll
                for (int bj = 0; bj < 2; ++bj) { const f32x4 v0 = acc[ai][bj][m][0] * r, v1 = acc[ai][bj][m][1] * r;
                    int w0 = __builtin_amdgcn_cvt_pk_fp8_f32(v0[0], v0[1], 0, false); w0 = __builtin_amdgcn_cvt_pk_fp8_f32(v0[2], v0[3], w0, true);
                    int w1 = __builtin_amdgcn_cvt_pk_fp8_f32(v1[0], v1[1], 0, false); w1 = __builtin_amdgcn_cvt_pk_fp8_f32(v1[2], v1[3], w1, true);
                    *(u32x2*)(rowp + bj * HALF) = (u32x2){(unsigned)w0, (unsigned)w1}; } }
    }
};
struct EpiPlainBf16 {
    static constexpr bool PERM = true, AFTER_DRAIN = false, KHOOK = false;
    bf16_t* O; int ldc;
    __device__ __forceinline__ void operator()(const f32x4 (&acc)[2][2][4][2], const Unit& u, int wr, int wc, int fr, int fq) const {
        const int row0 = u.pm * BM + wr * 64 + fr; const int col0 = u.pn * BM + wc * 32 + 8 * fq;
#pragma unroll
        for (int ai = 0; ai < 2; ++ai)
#pragma unroll
            for (int m = 0; m < 4; ++m) { bf16_t* rowp = O + (size_t)(row0 + ai * HALF + m * 16) * ldc + col0;
#pragma unroll
                for (int bj = 0; bj < 2; ++bj) *(u32x4*)(rowp + bj * HALF) = pack8(acc[ai][bj][m][0], acc[ai][bj][m][1]); }
    }
};
struct MoeOrder {
    const int* blk_expert; int nunits, G, c, sh;
    __device__ __forceinline__ bool next(int i, Unit& u) const {
        const int L = i * G + c; if (L >= nunits) return false;
        u.pm = __builtin_amdgcn_readfirstlane(L >> sh); u.pn = __builtin_amdgcn_readfirstlane((blk_expert[u.pm] << sh) + (L & ((1 << sh) - 1))); return true;
    }
    __device__ __forceinline__ void a_ready(const Unit&) const {}
    __device__ __forceinline__ void done(const Unit&) const {}
};

struct MoeTailOrder {
    const int* blk_expert; int L0, mainblk; unsigned* flg; int lane;
    __device__ __forceinline__ bool next(int i, Unit& u) const { if (i != 0) return false;
        u.pm = __builtin_amdgcn_readfirstlane(L0 >> 1); u.pn = __builtin_amdgcn_readfirstlane((blk_expert[u.pm] << 1) + (L0 & 1)); return true; }
    __device__ __forceinline__ void a_ready(const Unit&) const {}
    __device__ __forceinline__ void done(const Unit& u) const {
        asm volatile("s_waitcnt vmcnt(0)" ::: "memory");
        if (lane == 0) (void)__hip_atomic_fetch_add(&flg[64 * (u.pm - mainblk)], 1u, __ATOMIC_RELAXED, __HIP_MEMORY_SCOPE_AGENT);
    }
};
struct MoeOrderY {
    const int* blk_expert; int nunits, G, c, T, SKIP, mainblk, RG; unsigned* flg; int lane;
    __device__ __forceinline__ bool next(int i, Unit& u) const {
        int L;
        if (c >= T) L = (i < SKIP) ? i * (G - T) + (c - T) : SKIP * (G - T) + (i - SKIP) * G + c;
        else L = SKIP * (G - T) + i * G + c;
        if (L >= nunits) return false;
        u.pm = __builtin_amdgcn_readfirstlane(L >> 2); u.pn = __builtin_amdgcn_readfirstlane((blk_expert[u.pm] << 2) + (L & 3)); return true;
    }
    __device__ __forceinline__ void a_ready(const Unit& u) const {
        if (u.pm >= mainblk) {
            const unsigned need = 8u * (unsigned)((2 * u.pm >= RG ? 1 : 0) + (2 * u.pm + 1 >= RG ? 1 : 0));
            if (lane == 0) { unsigned sp = 0u; while (__hip_atomic_load(&flg[64 * (u.pm - mainblk)], __ATOMIC_RELAXED, __HIP_MEMORY_SCOPE_AGENT) < need) { __builtin_amdgcn_s_sleep(2); if (++sp > (1u << 22)) break; } }
            __builtin_amdgcn_fence(__ATOMIC_ACQUIRE, "agent");
        }
    }
    __device__ __forceinline__ void done(const Unit&) const {}
};

template <class Epi, class Sched, bool ALIGN_EPI = false, bool SP2 = false, bool GATHER = false>
__device__ __forceinline__ void gemm_phase(PG8_LAS unsigned char* lds, const Gemm g, const Sched& S, const Epi& E, const PG8_LAS int* gidx = nullptr) {
    const int tid = tid_now(), wid = __builtin_amdgcn_readfirstlane(tid >> 6), lane = tid & 63, wr = wid >> 2, wc = wid & 3, fr = lane & 15, fq = lane >> 4;
    const int K = g.K, nt = K / BK; const int lda = g.lda, ldb = g.ldb;
    unsigned voffA[2], voffB[2]; int Rg[2], Cg[2]; unsigned gA[2][2], gN[2][2];
#pragma unroll
    for (int i = 0; i < 2; ++i) { int R, C; stage_rc(tid * 16 + i * 8192, R, C); const int Rb = Epi::PERM ? ((R & ~31) + perm32(R & 31)) : R;
        voffA[i] = (unsigned)(R * lda + C) * 2u; voffB[i] = (unsigned)(Rb * ldb + C) * 2u; Rg[i] = R; Cg[i] = C; }
    const size_t kstep = (size_t)(BK * 2);
    const size_t hstepA = (size_t)HALF * lda * 2, hstepB = (size_t)HALF * ldb * 2;
    const size_t tstepA = 2 * hstepA, tstepB = 2 * hstepB;
    const unsigned ldsw = (unsigned)wid * 1024u;
    const int aoff = lds_byte(wr * 64 + fr, fq * 8), boff = lds_byte(wc * 32 + fr, fq * 8);
#define PG8_SA(b, h) (((b) * 2 + (h)) * HTB)
#define PG8_SB(b, h) ((4 + (b) * 2 + (h)) * HTB)
#define PG8_STAGE(bufoff, gbase, voff) do { _Pragma("unroll") for (int _i = 0; _i < 2; ++_i) \
        __builtin_amdgcn_global_load_lds((const unsigned*)((const char*)(gbase) + (voff)[_i]), (PG8_LAS unsigned*)(lds + (bufoff) + ldsw + _i * 8192), 16, 0, 0); } while (0)
#define PG8_GOFF(dst, ui_) do { _Pragma("unroll") for (int _h = 0; _h < 2; ++_h) _Pragma("unroll") for (int _i = 0; _i < 2; ++_i) dst[_h][_i] = ((unsigned)gidx[(ui_) * 256 + _h * HALF + Rg[_i]] * (unsigned)lda + (unsigned)Cg[_i]) * 2u; } while (0)
#define PG8_STAGE_A(bufoff, gbase, H, USE_NEXT) do { if constexpr (GATHER) { _Pragma("unroll") for (int _i = 0; _i < 2; ++_i) { const unsigned _o = (USE_NEXT) ? gN[H][_i] : gA[H][_i]; \
        __builtin_amdgcn_global_load_lds((const unsigned*)((const char*)(gbase) + _o), (PG8_LAS unsigned*)(lds + (bufoff) + ldsw + _i * 8192), 16, 0, 0); } } \
    else { PG8_STAGE(bufoff, (gbase) + ((H) ? hstepA : 0), voffA); } } while (0)
#define PG8_LDA(dst, b, h) do { _Pragma("unroll") for (int m = 0; m < 4; ++m) _Pragma("unroll") for (int k = 0; k < 2; ++k) dst[m][k] = *(const PG8_LAS bf16x8*)(lds + PG8_SA(b, h) + aoff + m * 2048 + k * 1024); } while (0)
#define PG8_LDB(dst, b, h) do { _Pragma("unroll") for (int n = 0; n < 2; ++n) _Pragma("unroll") for (int k = 0; k < 2; ++k) dst[n][k] = *(const PG8_LAS bf16x8*)(lds + PG8_SB(b, h) + boff + n * 2048 + k * 1024); } while (0)
#define PG8_MMA(ai, bj, At, Bt) do { __builtin_amdgcn_s_setprio(1); _Pragma("unroll") for (int m = 0; m < 4; ++m) _Pragma("unroll") for (int n = 0; n < 2; ++n) _Pragma("unroll") for (int k = 0; k < 2; ++k) \
        acc[ai][bj][m][n] = __builtin_amdgcn_mfma_f32_16x16x32_bf16(Bt[n][k], At[m][k], acc[ai][bj][m][n], 0, 0, 0); __builtin_amdgcn_s_setprio(0); } while (0)
#define PG8_WAIT_V(n) asm volatile("s_waitcnt vmcnt(" #n ")" ::: "memory")
#define PG8_WAIT_L(n) asm volatile("s_waitcnt lgkmcnt(" #n ")" ::: "memory")
#define PG8_BAR __builtin_amdgcn_s_barrier()
#define PG8_SCHED __builtin_amdgcn_sched_barrier(0)
    Unit cur, nxt; int ui = 0;
    if (!S.next(0, cur)) return;
    f32x4 acc[2][2][4][2];
#pragma unroll
    for (int a = 0; a < 2; ++a)
#pragma unroll
        for (int b = 0; b < 2; ++b)
#pragma unroll
            for (int m = 0; m < 4; ++m)
#pragma unroll
                for (int n = 0; n < 2; ++n) acc[a][b][m][n] = (f32x4){0.f, 0.f, 0.f, 0.f};
    bf16x8 At[4][2], B0[2][2], B1[2][2];
    const char* cA = (const char*)g.A + (GATHER ? (size_t)0 : (size_t)cur.pm * tstepA); if constexpr (GATHER) { PG8_GOFF(gA, 0); }
    const char* cB = (const char*)g.Bt + (size_t)cur.pn * tstepB;
    S.a_ready(cur);
    if constexpr (SP2) {
        PG8_STAGE(PG8_SB(0, 0), cB, voffB); PG8_STAGE(PG8_SB(0, 1), cB + hstepB, voffB); PG8_STAGE_A(PG8_SA(0, 0), cA, 0, false); PG8_STAGE_A(PG8_SA(0, 1), cA, 1, false);
        if (wr == 1) PG8_BAR;
        PG8_WAIT_V(2); PG8_BAR;
        PG8_STAGE(PG8_SB(1, 0), cB + kstep, voffB); PG8_STAGE_A(PG8_SA(1, 0), cA + kstep, 0, false); PG8_STAGE(PG8_SB(1, 1), cB + hstepB + kstep, voffB);
        PG8_WAIT_V(6); PG8_BAR;
    } else {
        PG8_STAGE(PG8_SB(0, 0), cB, voffB); PG8_STAGE_A(PG8_SA(0, 0), cA, 0, false); PG8_STAGE(PG8_SB(0, 1), cB + hstepB, voffB); PG8_STAGE_A(PG8_SA(0, 1), cA, 1, false);
        if (wr == 1) PG8_BAR;
        PG8_WAIT_V(4); PG8_BAR;
        PG8_STAGE(PG8_SB(1, 0), cB + kstep, voffB); PG8_STAGE_A(PG8_SA(1, 0), cA + kstep, 0, false); PG8_STAGE(PG8_SB(1, 1), cB + hstepB + kstep, voffB);
        PG8_WAIT_V(6); PG8_BAR;
    }
    for (;;) {
        const bool has_next = S.next(ui + 1, nxt);
        const char* nA = (has_next && !GATHER) ? (const char*)g.A + (size_t)nxt.pm * tstepA : cA;
        if constexpr (GATHER) { if (has_next) { PG8_GOFF(gN, ui + 1); } else { _Pragma("unroll") for (int _h = 0; _h < 2; ++_h) _Pragma("unroll") for (int _i = 0; _i < 2; ++_i) gN[_h][_i] = gA[_h][_i]; } }
        const char* nB = has_next ? (const char*)g.Bt + (size_t)nxt.pn * tstepB : cB;
#pragma unroll 1
        for (int t = 0; t < nt; t += 2) {
            if constexpr (Epi::KHOOK) E.khook(acc, t, ui, wr, fr);
            const bool last = (t == nt - 2);
            const char* a1 = cA + (size_t)(t + 1) * kstep;
            const char* a2 = last ? nA : cA + (size_t)(t + 2) * kstep; const char* b2 = last ? nB : cB + (size_t)(t + 2) * kstep;
            const char* a3 = a2 + kstep; const char* b3 = b2 + kstep;
            if (last && has_next) S.a_ready(nxt);
            if constexpr (SP2) {
            PG8_LDB(B0, 0, 0); PG8_LDB(B1, 0, 1); PG8_SCHED; PG8_LDA(At, 0, 0); PG8_STAGE_A(PG8_SA(1, 1), a1, 1, false);
            PG8_WAIT_V(8); PG8_WAIT_L(0); PG8_BAR; PG8_MMA(0, 0, At, B0); PG8_MMA(0, 1, At, B1); PG8_BAR; PG8_SCHED;
            PG8_LDA(At, 0, 1); PG8_STAGE(PG8_SB(0, 0), b2, voffB); PG8_STAGE(PG8_SB(0, 1), b2 + hstepB, voffB); PG8_STAGE_A(PG8_SA(0, 0), a2, 0, last);
            PG8_WAIT_V(8); PG8_WAIT_L(0); PG8_BAR; PG8_MMA(1, 0, At, B0); PG8_MMA(1, 1, At, B1); PG8_BAR; PG8_SCHED;
            PG8_LDB(B0, 1, 0); PG8_LDB(B1, 1, 1); PG8_SCHED; PG8_LDA(At, 1, 0); PG8_STAGE_A(PG8_SA(0, 1), a2, 1, last);
            PG8_WAIT_V(8); PG8_WAIT_L(0); PG8_BAR; PG8_MMA(0, 0, At, B0); PG8_MMA(0, 1, At, B1); PG8_BAR; PG8_SCHED;
            PG8_LDA(At, 1, 1); PG8_STAGE(PG8_SB(1, 0), b3, voffB); PG8_STAGE(PG8_SB(1, 1), b3 + hstepB, voffB); PG8_STAGE_A(PG8_SA(1, 0), a3, 0, last);
            PG8_WAIT_V(8); PG8_WAIT_L(0); PG8_BAR; PG8_MMA(1, 0, At, B0); PG8_MMA(1, 1, At, B1); PG8_BAR; PG8_SCHED;
            } else {
            PG8_LDB(B0, 0, 0); PG8_SCHED; PG8_LDA(At, 0, 0); PG8_STAGE_A(PG8_SA(1, 1), a1, 1, false);
            PG8_WAIT_L(8); PG8_BAR; PG8_WAIT_L(0); PG8_MMA(0, 0, At, B0); PG8_BAR; PG8_SCHED;
            PG8_LDB(B1, 0, 1); PG8_STAGE(PG8_SB(0, 0), b2, voffB);
            PG8_BAR; PG8_WAIT_L(0); PG8_MMA(0, 1, At, B1); PG8_BAR;
            PG8_LDA(At, 0, 1); PG8_STAGE_A(PG8_SA(0, 0), a2, 0, last);
            PG8_BAR; PG8_WAIT_L(0); PG8_MMA(1, 0, At, B0); PG8_BAR; PG8_SCHED;
            PG8_STAGE(PG8_SB(0, 1), b2 + hstepB, voffB);
            PG8_WAIT_V(6); PG8_BAR; PG8_MMA(1, 1, At, B1); PG8_BAR;
            PG8_LDB(B0, 1, 0); PG8_SCHED; PG8_LDA(At, 1, 0); PG8_STAGE_A(PG8_SA(0, 1), a2, 1, last);
            PG8_WAIT_L(8); PG8_BAR; PG8_WAIT_L(0); PG8_MMA(0, 0, At, B0); PG8_BAR; PG8_SCHED;
            PG8_LDB(B1, 1, 1); PG8_STAGE(PG8_SB(1, 0), b3, voffB);
            PG8_BAR; PG8_WAIT_L(0); PG8_MMA(0, 1, At, B1); PG8_BAR;
            PG8_LDA(At, 1, 1); PG8_STAGE_A(PG8_SA(1, 0), a3, 0, last);
            PG8_BAR; PG8_WAIT_L(0); PG8_MMA(1, 0, At, B0); PG8_BAR; PG8_SCHED;
            PG8_STAGE(PG8_SB(1, 1), b3 + hstepB, voffB);
            PG8_WAIT_V(6); PG8_BAR; PG8_MMA(1, 1, At, B1); PG8_BAR;
            }
        }
        if constexpr (ALIGN_EPI) { if (wr == 0) PG8_BAR; }
        if constexpr (!Epi::AFTER_DRAIN) { E(acc, cur, wr, wc, fr, fq); S.done(cur); }
        if (!has_next) break;
#pragma unroll
        for (int a = 0; a < 2; ++a)
#pragma unroll
            for (int b = 0; b < 2; ++b)
#pragma unroll
                for (int m = 0; m < 4; ++m)
#pragma unroll
                    for (int n = 0; n < 2; ++n) acc[a][b][m][n] = (f32x4){0.f, 0.f, 0.f, 0.f};
        cur = nxt; cA = nA; cB = nB; ++ui;
        if constexpr (GATHER) { _Pragma("unroll") for (int _h = 0; _h < 2; ++_h) _Pragma("unroll") for (int _i = 0; _i < 2; ++_i) gA[_h][_i] = gN[_h][_i]; }
        if constexpr (ALIGN_EPI) { if (wr == 1) PG8_BAR; }
    }
    PG8_WAIT_V(0);
    if constexpr (!ALIGN_EPI) { if (wr == 0) PG8_BAR; }
    PG8_BAR;
    if constexpr (Epi::AFTER_DRAIN) { E.fused(acc, cur, wr, wc, fr, fq, lds, wid, lane); S.done(cur); }
#undef PG8_SA
#undef PG8_SB
#undef PG8_STAGE
#undef PG8_GOFF
#undef PG8_STAGE_A
#undef PG8_LDA
#undef PG8_LDB
#undef PG8_MMA
#undef PG8_WAIT_V
#undef PG8_WAIT_L
#undef PG8_BAR
#undef PG8_SCHED
}
}

#ifndef PG8_SP2
#define PG8_SP2 true
#endif
#ifndef PG8_ALIGN
#define PG8_ALIGN true
#endif

constexpr int NB = 8, SEQ = 4096, D = 1024, M = NB * SEQ;
constexpr int NL = 2;
constexpr int MEMLEN = 256, MM = NB * MEMLEN;
constexpr int UW = 2048;
constexpr int INC = 1952;
constexpr int NEXP = 32, DEXP = 256;
constexpr int PSLOTS = 73728;
constexpr int NBLK_MAX = PSLOTS / 256;
constexpr float EPS = 1e-6f;
constexpr float LOG2E = 1.4426950408889634f;
constexpr int NWAVES = 8, NTHR = 512;

constexpr int UC_CQ = 0, UC_CKV = 256, UC_ROPE = 384, UC_POOL = 512, UC_SQ = 768, UC_SK = 1024, UC_SV = 1152, UC_CB = 1280, UC_CC = 1536, UC_CH = 1792;
constexpr int QC_KR = 384, QC_KV = 512;

constexpr size_t MiB = 1u << 20;
constexpr size_t WS_CTL = 0, CTL_ZERO_BYTES = 1 * MiB;
constexpr size_t WL_IN = 0, WL_UP = WL_IN + (size_t)UW * D * 2, WL_MIX = WL_UP + (size_t)1024 * 384 * 2, WL_XQ = WL_MIX + (size_t)D * D * 2, WL_XO = WL_XQ + (size_t)256 * D * 2,
                 WL_R = WL_XO + (size_t)D * 256 * 2, WL_GU = WL_R + (size_t)256 * D * 2, WL_DN = WL_GU + (size_t)NEXP * 512 * D * 2, WL_END = WL_DN + (size_t)NEXP * D * 256 * 2;
static_assert(WL_END <= 57 * MiB, "per-layer weights");
constexpr size_t WS_W = 1 * MiB;
constexpr size_t WS_XKV = WS_W + 2 * 57 * MiB;
constexpr size_t WS_MN = WS_XKV + 2 * MiB;
constexpr size_t WS_KVX = WS_MN + 4 * MiB;
constexpr size_t WS_STQ = WS_KVX + 4 * MiB;
constexpr size_t WS_STKV = WS_STQ + (size_t)4 * M * 4;
constexpr size_t WS_STX = WS_STKV + (size_t)4 * M * 4;
constexpr size_t WS_LOG = WS_STX + (size_t)16 * M * 4;
constexpr size_t WS_EID = WS_LOG + (size_t)M * 64 * 4;
constexpr size_t WS_WT = WS_EID + (size_t)M * 2 * 4;
constexpr size_t WS_SLOT = WS_WT + (size_t)M * 2 * 4;
constexpr size_t WS_WSLOT = WS_SLOT + (size_t)M * 2 * 4;
constexpr size_t WS_HIST = WS_WSLOT + (size_t)PSLOTS * 4;
constexpr size_t WS_BLKE = WS_HIST + (size_t)256 * 32 * 4;
constexpr size_t WS_TOK = WS_BLKE + 4096;
constexpr size_t WS_RSLOT = WS_TOK + (size_t)PSLOTS * 4;
constexpr size_t WS_XB = 144 * MiB;
static_assert(WS_RSLOT + (size_t)PSLOTS * 4 <= WS_XB && (NBLK_MAX + 16) * 4 <= 4096, "small buffers");
constexpr size_t WS_R1 = WS_XB + 64 * MiB;
constexpr size_t WS_U = WS_R1, WS_QKV = WS_R1 + 128 * MiB, WS_XG = WS_R1, WS_YB = WS_R1;
constexpr size_t WS_Y = WS_R1 + 192 * MiB;
constexpr size_t WS_H = WS_Y;
constexpr size_t WS_QX = WS_Y + 64 * MiB;
constexpr size_t WS_OX = WS_QX + 16 * MiB;
constexpr size_t WS_END0 = WS_OX + 16 * MiB;
constexpr int ECAP = 32768;
constexpr size_t WS_TOKR = WS_END0;
constexpr size_t WS_RSR = WS_TOKR + (size_t)NEXP * ECAP * 4;
constexpr size_t WS_WR = WS_RSR + (size_t)NEXP * ECAP * 4;
constexpr size_t WS_END = WS_WR + (size_t)NEXP * ECAP * 4;
static_assert(WS_END <= 512 * MiB, "workspace");
constexpr int CW_BAR = 4096;
constexpr int CW_FQ = 81920, CW_FO = 98304;
constexpr int CW_FLG = 16384;
constexpr int CW_CNT = 8192;

constexpr int RING_OFF = 0, RING_BYTES = 131072;
constexpr int LDSCTL_OFF = 143360, MISC_OFF = LDSCTL_OFF + 320;
constexpr int LDS_BYTES = 147456;

#define GAS __attribute__((address_space(1)))
#define LAS __attribute__((address_space(3)))
typedef unsigned short bf16;
typedef unsigned v4u __attribute__((ext_vector_type(4)));
typedef unsigned v2u __attribute__((ext_vector_type(2)));
typedef float f32x4 __attribute__((ext_vector_type(4)));
typedef float f32x16 __attribute__((ext_vector_type(16)));
typedef short bf16x8 __attribute__((ext_vector_type(8)));
typedef short s16x4 __attribute__((ext_vector_type(4)));
typedef GAS unsigned gu32;
#define RLX_AGENT __ATOMIC_RELAXED, __HIP_MEMORY_SCOPE_AGENT
#define LDS_WAIT() asm volatile("s_waitcnt lgkmcnt(0)" ::: "memory")
#define VM_WAIT() asm volatile("s_waitcnt vmcnt(0)" ::: "memory")
__device__ __forceinline__ unsigned f2bf(float f) { unsigned u = __builtin_bit_cast(unsigned, f); return (u + 0x7fffu + ((u >> 16) & 1u)) >> 16; }
__device__ __forceinline__ unsigned pk2(float lo, float hi) { return f2bf(lo) | (f2bf(hi) << 16); }
__device__ __forceinline__ float bf2f(unsigned h) { return __builtin_bit_cast(float, h << 16); }
__device__ __forceinline__ float bflo(unsigned w) { return __builtin_bit_cast(float, w << 16); }
__device__ __forceinline__ float bfhi(unsigned w) { return __builtin_bit_cast(float, w & 0xffff0000u); }
__device__ __forceinline__ float wave_sum(float v) {
#pragma unroll
    for (int o = 1; o < 64; o <<= 1) v += __shfl_xor(v, o);
    return v;
}
__device__ __forceinline__ float sum16(float v) { v += __shfl_xor(v, 1); v += __shfl_xor(v, 2); v += __shfl_xor(v, 4); v += __shfl_xor(v, 8); return v; }
__device__ __forceinline__ float sum32(float v) { v = sum16(v); v += __shfl_xor(v, 16); return v; }

#define XB_TMO      128
#define XB_XCNT(j)  (256  + 64 * (j))
#define XB_XSUB(j)  (1280 + 64 * (j))
#define XB_XGEN(j)  (2304 + 64 * (j))
#define XB_TOP      3328
#define XB_TOPGEN   3392
#define XCD_BAR_WORDS 3456
#define XB_SPIN_CAP (1u << 18)
__device__ __forceinline__ unsigned xb_ld(unsigned* p)              { return __hip_atomic_load(p, __ATOMIC_RELAXED, __HIP_MEMORY_SCOPE_AGENT); }
__device__ __forceinline__ unsigned xb_add(unsigned* p, unsigned v) { return __hip_atomic_fetch_add(p, v, __ATOMIC_RELAXED, __HIP_MEMORY_SCOPE_AGENT); }
__device__ __forceinline__ unsigned xb_xcc_id() { return (unsigned)__builtin_amdgcn_s_getreg((3 << 11) | 20) & 0xFu; }
#define XB_SPIN(cond, bar) do { unsigned _sp = 0; while (cond) { __builtin_amdgcn_s_sleep(1); \
    if ((++_sp & 255u) == 0u) { if (xb_ld(&(bar)[XB_TMO])) break; if (_sp > XB_SPIN_CAP) { atomicAdd(&(bar)[XB_TMO], 1u); break; } } } } while (0)
struct XcdBarrier { unsigned* bar; unsigned x; volatile LAS unsigned* st; };
__device__ __forceinline__ XcdBarrier xcd_barrier_post(unsigned* bar, volatile LAS unsigned* st) {
    XcdBarrier b; b.bar = bar; b.x = xb_xcc_id(); b.st = st;
    if (threadIdx.x == 0) (void)xb_add(&bar[XB_XCNT(b.x)], 1u);
    return b;
}
__device__ __forceinline__ void xcd_barrier_complete(unsigned* bar, unsigned x, unsigned& nloc, unsigned& nx) {
    const unsigned G = (unsigned)kernarg_G();
    unsigned sum, cnt, mine, sp = 0u;
    for (;;) {
        sum = 0u; cnt = 0u; mine = 0u;
#pragma unroll
        for (unsigned j = 0; j < 16; ++j) { const unsigned c = xb_ld(&bar[XB_XCNT(j)]); sum += c; cnt += (c > 0u) ? 1u : 0u; mine = (j == x) ? c : mine; }
        if (sum == G) break;
        __builtin_amdgcn_s_sleep(1);
        if ((++sp & 255u) == 0u) { if (xb_ld(&bar[XB_TMO])) break; if (sp > XB_SPIN_CAP) { atomicAdd(&bar[XB_TMO], 1u); break; } }
    }
    nloc = mine > 0u ? mine : 1u; nx = cnt > 0u ? cnt : 1u;
}
__device__ __forceinline__ void xcd_barrier(const XcdBarrier& b) {
    asm volatile("s_waitcnt vmcnt(0)" ::: "memory");
    __syncthreads();
    if (threadIdx.x == 0) {
        unsigned* bar = b.bar;
        __builtin_amdgcn_s_waitcnt(0);
        unsigned nloc = b.st[0], nx = b.st[1];
        if (nloc == 0u) { xcd_barrier_complete(bar, b.x, nloc, nx); b.st[0] = nloc; b.st[1] = nx; }
        const unsigned old = xb_add(&bar[XB_XSUB(b.x)], 1u);
        const unsigned gen = old / nloc;
        if (old + 1u == (gen + 1u) * nloc) {
            __builtin_amdgcn_fence(__ATOMIC_RELEASE, "agent");
            asm volatile("s_waitcnt vmcnt(0)" ::: "memory");
            const unsigned og = xb_add(&bar[XB_TOP], 1u);
            const unsigned tg = og / nx;
            if (og + 1u == (tg + 1u) * nx) xb_add(&bar[XB_TOPGEN], 1u);
            else XB_SPIN(xb_ld(&bar[XB_TOPGEN]) == tg, bar);
            __builtin_amdgcn_fence(__ATOMIC_ACQUIRE, "agent");
            xb_add(&bar[XB_XGEN(b.x)], 1u);
            asm volatile("s_waitcnt vmcnt(0)" ::: "memory");
        } else {
            XB_SPIN(xb_ld(&bar[XB_XGEN(b.x)]) == gen, bar);
            __builtin_amdgcn_fence(__ATOMIC_ACQUIRE, "agent");
            asm volatile("s_waitcnt vmcnt(0)" ::: "memory");
        }
    }
    __syncthreads();
}

struct Frame {
    LAS unsigned char* lds; volatile LAS unsigned* MISC;
    int tid, lane, wave, vcu, G, gw, NGW, bx;
    unsigned char* ws; float* X;
};

__device__ __forceinline__ void tr_item(const float* src, int ldw, const float* gain, bf16* dst, int ldt, LAS float* scr, int lane) {
    f32x4 v[8]; float gv[8];
#pragma unroll
    for (int i = 0; i < 8; ++i) { const int kk = (lane >> 3) + 8 * i; v[i] = *(const GAS f32x4*)(src + (size_t)kk * ldw + 4 * (lane & 7)); gv[i] = gain ? gain[kk] : 1.0f; }
#pragma unroll
    for (int i = 0; i < 8; ++i) { const int kk = (lane >> 3) + 8 * i; LAS float* p = scr + kk * 33 + 4 * (lane & 7); p[0] = v[i].x * gv[i]; p[1] = v[i].y * gv[i]; p[2] = v[i].z * gv[i]; p[3] = v[i].w * gv[i]; }
    LDS_WAIT(); asm volatile("" ::: "memory");
    const int c = lane & 7;
#pragma unroll
    for (int j = 0; j < 4; ++j) { const int n = (lane >> 3) + 8 * j; const LAS float* sp = scr + (8 * c) * 33 + n;
        v4u o; o.x = pk2(sp[0 * 33], sp[1 * 33]); o.y = pk2(sp[2 * 33], sp[3 * 33]); o.z = pk2(sp[4 * 33], sp[5 * 33]); o.w = pk2(sp[6 * 33], sp[7 * 33]);
        *(GAS v4u*)(dst + (size_t)n * ldt + 8 * c) = o; }
    LDS_WAIT(); asm volatile("" ::: "memory");
}
constexpr int IT_IN = 16 * 53, IT_POOL = 128 * 8, IT_ZIN = 96, IT_UQ = 4 * 12, IT_UKV = 2 * 16, IT_ZUP = 1024, IT_MIX = 16 * 32, IT_XQ = 16 * 8, IT_XKV = 16 * 16, IT_XO = 4 * 32,
              IT_RE = 16, IT_RG = 16, IT_GU = NEXP * 256, IT_DN = NEXP * 128;
constexpr int IT_O_POOL = IT_GU + IT_DN + IT_IN, IT_O_XKV = IT_O_POOL + IT_POOL + IT_ZIN + IT_UQ + IT_UKV + IT_ZUP + IT_MIX + IT_XQ;
constexpr int IT_LAYER = IT_IN + IT_POOL + IT_ZIN + IT_UQ + IT_UKV + IT_ZUP + IT_MIX + IT_XQ + IT_XKV + IT_XO + IT_RE + IT_RG + IT_GU + IT_DN;

template <int NI> __device__ __forceinline__ void tr_items(const float* const (&src)[NI], int ldw, const float* const (&gain)[NI], bf16* const (&dst)[NI], int ldt, LAS float* scr, int lane) {
    f32x4 v[NI][8]; float gv[NI][8];
#pragma unroll
    for (int q = 0; q < NI; ++q)
#pragma unroll
        for (int i = 0; i < 8; ++i) { const int kk = (lane >> 3) + 8 * i; v[q][i] = *(const GAS f32x4*)(src[q] + (size_t)kk * ldw + 4 * (lane & 7)); gv[q][i] = gain[q] ? gain[q][kk] : 1.0f; }
#pragma unroll
    for (int q = 0; q < NI; ++q)
#pragma unroll
        for (int i = 0; i < 8; ++i) { const int kk = (lane >> 3) + 8 * i; LAS float* p = scr + q * 2112 + kk * 33 + 4 * (lane & 7); p[0] = v[q][i].x * gv[q][i]; p[1] = v[q][i].y * gv[q][i]; p[2] = v[q][i].z * gv[q][i]; p[3] = v[q][i].w * gv[q][i]; }
    LDS_WAIT(); asm volatile("" ::: "memory");
    const int c = lane & 7;
#pragma unroll
    for (int q = 0; q < NI; ++q)
#pragma unroll
        for (int j = 0; j < 4; ++j) { const int n = (lane >> 3) + 8 * j; const LAS float* sp = scr + q * 2112 + (8 * c) * 33 + n;
            v4u o; o.x = pk2(sp[0 * 33], sp[1 * 33]); o.y = pk2(sp[2 * 33], sp[3 * 33]); o.z = pk2(sp[4 * 33], sp[5 * 33]); o.w = pk2(sp[6 * 33], sp[7 * 33]);
            *(GAS v4u*)(dst[q] + (size_t)n * ldt + 8 * c) = o; }
    LDS_WAIT(); asm volatile("" ::: "memory");
}
template <int NI> __device__ __forceinline__ void tr_items16(const float* const (&src)[NI], int ldw, const float* const (&gain)[NI], bf16* const (&dst)[NI], int ldt, LAS unsigned short* scr, int lane) {
    f32x4 v[NI][8]; float gv[NI][8];
#pragma unroll
    for (int q = 0; q < NI; ++q)
#pragma unroll
        for (int i = 0; i < 8; ++i) { const int kk = (lane >> 3) + 8 * i; v[q][i] = *(const GAS f32x4*)(src[q] + (size_t)kk * ldw + 4 * (lane & 7)); gv[q][i] = gain[q] ? gain[q][kk] : 1.0f; }
#pragma unroll
    for (int q = 0; q < NI; ++q)
#pragma unroll
        for (int i = 0; i < 8; ++i) { const int kk = (lane >> 3) + 8 * i; LAS unsigned short* p = scr + q * 2176 + kk * 34 + 4 * (lane & 7);
            p[0] = (unsigned short)f2bf(v[q][i].x * gv[q][i]); p[1] = (unsigned short)f2bf(v[q][i].y * gv[q][i]); p[2] = (unsigned short)f2bf(v[q][i].z * gv[q][i]); p[3] = (unsigned short)f2bf(v[q][i].w * gv[q][i]); }
    LDS_WAIT(); asm volatile("" ::: "memory");
    const int c = lane & 7;
#pragma unroll
    for (int q = 0; q < NI; ++q)
#pragma unroll
        for (int j = 0; j < 4; ++j) { const int n = (lane >> 3) + 8 * j; const LAS unsigned short* sp = scr + q * 2176 + (8 * c) * 34 + n;
            v4u o; o.x = (unsigned)sp[0 * 34] | ((unsigned)sp[1 * 34] << 16); o.y = (unsigned)sp[2 * 34] | ((unsigned)sp[3 * 34] << 16); o.z = (unsigned)sp[4 * 34] | ((unsigned)sp[5 * 34] << 16); o.w = (unsigned)sp[6 * 34] | ((unsigned)sp[7 * 34] << 16);
            *(GAS v4u*)(dst[q] + (size_t)n * ldt + 8 * c) = o; }
    LDS_WAIT(); asm volatile("" ::: "memory");
}
template <int WHICH> __device__ __forceinline__ void expert_item(const Frame& F, int l, int r, const float*& src, const float*& gain, bf16*& dst) {
    unsigned char* wl = F.ws + WS_W + (size_t)l * 57 * MiB;
    if (WHICH == 0) { const int e = r >> 8, q = r & 255, which = q >> 7, q2 = q & 127, kb = q2 >> 3, nb = q2 & 7, n0 = 32 * nb;
        const float* W = (which ? (const float*)ARGP(33) : (const float*)ARGP(32)) + ((size_t)l * NEXP + e) * D * DEXP;
        src = W + (size_t)(64 * kb) * DEXP + n0; gain = (const float*)ARGP(27) + (size_t)l * D + 64 * kb;
        dst = (bf16*)(wl + WL_GU) + ((size_t)e * 512 + 256 * (n0 >> 7) + 128 * which + (n0 & 127)) * D + 64 * kb; }
    else { const int e = r >> 7, q = r & 127, kb = q >> 5, nb = q & 31;
        const float* W = (const float*)ARGP(34) + ((size_t)l * NEXP + e) * DEXP * D;
        src = W + (size_t)(64 * kb) * D + 32 * nb; gain = nullptr; dst = (bf16*)(wl + WL_DN) + ((size_t)e * D + 32 * nb) * DEXP + 64 * kb; }
}
template <int WHICH> __device__ __forceinline__ void prep_experts(const Frame& F, int l, int w0, int nw) {
    LAS float* scr = (LAS float*)(F.lds + RING_OFF + F.wave * 17408);
    constexpr int NIT = WHICH == 0 ? IT_GU : IT_DN, ldw = WHICH == 0 ? DEXP : D, ldt = WHICH == 0 ? D : DEXP;
    int it = w0;
    for (; it + 3 * nw < NIT; it += 4 * nw) { const float* src[4]; const float* gain[4]; bf16* dst[4];
#pragma unroll
        for (int q = 0; q < 4; ++q) expert_item<WHICH>(F, l, it + q * nw, src[q], gain[q], dst[q]);
        tr_items16<4>(src, ldw, gain, dst, ldt, (LAS unsigned short*)scr, F.lane); }
    for (; it + nw < NIT; it += 2 * nw) { const float* src[2]; const float* gain[2]; bf16* dst[2];
        expert_item<WHICH>(F, l, it, src[0], gain[0], dst[0]); expert_item<WHICH>(F, l, it + nw, src[1], gain[1], dst[1]);
        tr_items<2>(src, ldw, gain, dst, ldt, scr, F.lane); }
    for (; it < NIT; it += nw) { const float* src[1]; const float* gain[1]; bf16* dst[1];
        expert_item<WHICH>(F, l, it, src[0], gain[0], dst[0]); tr_items<1>(src, ldw, gain, dst, ldt, scr, F.lane); }
}
__device__ __forceinline__ void pool_item(const float* win, const float* wpool, const float* pscale, const float* gain, bf16* dst, int kb8, int nb, int lane) {
    const int k0 = 8 * kb8, n0 = 32 * nb, g = n0 >> 6, d0 = n0 & 63, nn = lane & 31, kh = lane >> 5;
    const float* wp = wpool + (size_t)g * 64 * 64 + d0 + nn; const float ps = pscale[n0 + nn];
    float wpr[64];
#pragma unroll
    for (int c = 0; c < 64; ++c) wpr[c] = wp[(size_t)c * 64];
    float r[4];
#pragma unroll
    for (int i = 0; i < 4; ++i) { const int kk = 4 * kh + i; const GAS f32x4* wr = (const GAS f32x4*)(win + (size_t)(k0 + kk) * INC + 416 + 64 * g); float a = 0.f;
#pragma unroll
        for (int hh = 0; hh < 4; ++hh) { f32x4 w4[4];
#pragma unroll
            for (int c = 0; c < 4; ++c) w4[c] = wr[4 * hh + c];
#pragma unroll
            for (int c = 0; c < 4; ++c) a += w4[c].x * wpr[16 * hh + 4 * c] + w4[c].y * wpr[16 * hh + 4 * c + 1] + w4[c].z * wpr[16 * hh + 4 * c + 2] + w4[c].w * wpr[16 * hh + 4 * c + 3];
            asm volatile("" ::: "memory"); }
        r[i] = a * ps * gain[k0 + kk]; }
    float o[4];
#pragma unroll
    for (int i = 0; i < 4; ++i) o[i] = __shfl_xor(r[i], 32);
    if (kh == 0) *(GAS v4u*)(dst + (size_t)(UC_POOL + n0 + nn) * D + k0) = (v4u){pk2(r[0], r[1]), pk2(r[2], r[3]), pk2(o[0], o[1]), pk2(o[2], o[3])};
}
__device__ __forceinline__ void zero_bf16(bf16* p, int n, int lane) { unsigned z = 0u; asm volatile("" : "+v"(z)); for (int i = lane * 8; i < n; i += 512) *(GAS v4u*)(p + i) = (v4u){z, z, z, z}; }

template <bool POOL = true> __device__ __forceinline__ void prep_weights(const Frame& F, int l0, int nl, int lo, int hi, int w0, int nw) {
    LAS float* scr = (LAS float*)(F.lds + RING_OFF + F.wave * 17408);
    const int span = hi - lo;
    for (int it0 = w0; it0 < nl * span; it0 += nw) {
        int lane = F.lane; asm volatile("" : "+v"(lane));
        const int l = l0 + it0 / span; int r = lo + it0 % span;
        unsigned char* wl = F.ws + WS_W + (size_t)l * 57 * MiB;
        bf16* Bin = (bf16*)(wl + WL_IN); bf16* Bup = (bf16*)(wl + WL_UP);
        const float* g_mix = (const float*)ARGP(3) + (size_t)l * D;
        const float* win = (const float*)ARGP(4) + (size_t)l * D * INC;
        if (r < IT_GU) { const int e = r >> 8, q = r & 255, which = q >> 7, q2 = q & 127, kb = q2 >> 3, nb = q2 & 7, n0 = 32 * nb;
            const float* W = (const float*)ARGP(which ? 33 : 32) + ((size_t)l * NEXP + e) * D * DEXP;
            bf16* dst = (bf16*)(wl + WL_GU) + ((size_t)e * 512 + 256 * (n0 >> 7) + 128 * which + (n0 & 127)) * D + 64 * kb;
            tr_item(W + (size_t)(64 * kb) * DEXP + n0, DEXP, (const float*)ARGP(27) + (size_t)l * D + 64 * kb, dst, D, scr, lane); continue; } r -= IT_GU;
        if (r < IT_DN) { const int e = r >> 7, q = r & 127, kb = q >> 5, nb = q & 31;
            const float* W = (const float*)ARGP(34) + ((size_t)l * NEXP + e) * DEXP * D;
            bf16* dst = (bf16*)(wl + WL_DN) + ((size_t)e * D + 32 * nb) * DEXP + 64 * kb;
            tr_item(W + (size_t)(64 * kb) * D + 32 * nb, D, nullptr, dst, DEXP, scr, lane); continue; } r -= IT_DN;
        if (r < IT_IN) { const int kb = r / 53, j = r % 53, ob = j < 13 ? j : j + 8, on0 = 32 * ob, nn0 = on0 + (ob >= 13 ? 96 : 0);
            tr_item(win + (size_t)(64 * kb) * INC + on0, INC, g_mix + 64 * kb, Bin + (size_t)nn0 * D + 64 * kb, D, scr, lane); continue; } r -= IT_IN;
        if (POOL && r < IT_POOL) { pool_item(win, (const float*)ARGP(11) + (size_t)l * 4 * 64 * 64, (const float*)ARGP(12) + (size_t)l * 256, g_mix, Bin, r >> 3, r & 7, lane); continue; } r -= IT_POOL;
        if (r < IT_ZIN) { zero_bf16(Bin + (size_t)(416 + r) * D, D, lane); continue; } r -= IT_ZIN;
        if (r < IT_UQ) { const int kb = r / 12, nb = r % 12;
            tr_item((const float*)ARGP(6) + (size_t)l * 256 * 384 + (size_t)(64 * kb) * 384 + 32 * nb, 384, (const float*)ARGP(5) + (size_t)l * 256 + 64 * kb, Bup + (size_t)(32 * nb) * 384 + 64 * kb, 384, scr, lane); continue; } r -= IT_UQ;
        if (r < IT_UKV) { const int kb = r / 16, nb = r % 16;
            tr_item((const float*)ARGP(8) + (size_t)l * 128 * 512 + (size_t)(64 * kb) * 512 + 32 * nb, 512, (const float*)ARGP(7) + (size_t)l * 128 + 64 * kb, Bup + (size_t)(512 + 32 * nb) * 384 + 256 + 64 * kb, 384, scr, lane); continue; } r -= IT_UKV;
        if (r < IT_ZUP) { bf16* row = Bup + (size_t)r * 384;
            if (r < 384) zero_bf16(row + 256, 128, lane); else if (r < 512) zero_bf16(row, 384, lane); else zero_bf16(row, 256, lane);
            continue; } r -= IT_ZUP;
        if (r < IT_MIX) { const int kb = r >> 5, nb = r & 31;
            tr_item((const float*)ARGP(19) + (size_t)l * D * D + (size_t)(64 * kb) * D + 32 * nb, D, (const float*)ARGP(18) + (size_t)l * D + 64 * kb, (bf16*)(wl + WL_MIX) + (size_t)(32 * nb) * D + 64 * ((kb & 3) + 4 * ((0x3120 >> (4 * (kb >> 2))) & 3)), D, scr, lane); continue; } r -= IT_MIX;
        if (r < IT_XQ) { const int kb = r >> 3, nb = r & 7;
            tr_item((const float*)ARGP(22) + (size_t)l * D * 256 + (size_t)(64 * kb) * 256 + 32 * nb, 256, (const float*)ARGP(20) + (size_t)l * D + 64 * kb, (bf16*)(wl + WL_XQ) + (size_t)(32 * nb) * D + 64 * kb, D, scr, lane); continue; } r -= IT_XQ;
        if (r < IT_XKV) { const int kb = r >> 4, nb = r & 15;
            tr_item((const float*)ARGP(23) + (size_t)l * D * 512 + (size_t)(64 * kb) * 512 + 32 * nb, 512, (const float*)ARGP(21) + (size_t)l * D + 64 * kb, (bf16*)(F.ws + WS_XKV) + (size_t)(512 * l + 32 * nb) * D + 64 * kb, D, scr, lane); continue; } r -= IT_XKV;
        if (r < IT_XO) { const int kb = r >> 5, nb = r & 31;
            tr_item((const float*)ARGP(26) + (size_t)l * 256 * D + (size_t)(64 * kb) * D + 32 * nb, D, nullptr, (bf16*)(wl + WL_XO) + (size_t)(32 * nb) * 256 + 64 * kb, 256, scr, lane); continue; } r -= IT_XO;
        const float* g_ffn = (const float*)ARGP(27) + (size_t)l * D;
        if (r < IT_RE) { const int kb = r;
            tr_item((const float*)ARGP(30) + (size_t)l * D * 32 + (size_t)(64 * kb) * 32, 32, g_ffn + 64 * kb, (bf16*)(wl + WL_R) + (size_t)4 * D + 64 * kb, D, scr, lane); continue; } r -= IT_RE;
        { const int k = 64 * r + lane; const float* wg = (const float*)ARGP(28) + (size_t)l * D * 4 + (size_t)k * 4; const float gv = g_ffn[k]; bf16* dst = (bf16*)(wl + WL_R);
#pragma unroll
          for (int n = 0; n < 4; ++n) dst[(size_t)n * D + k] = (bf16)f2bf(wg[n] * gv); }
    }
}
template <int UNR, bool NORM> __device__ __forceinline__ void rows_to_bf16(const float* x, bf16* o, float* stat, int row0, int rstride, int lane) {
    f32x4 v[UNR][4];
#pragma unroll
    for (int u = 0; u < UNR; ++u) { const GAS f32x4* xr = (const GAS f32x4*)(x + (size_t)(row0 + u * rstride) * D) + lane;
#pragma unroll
        for (int j = 0; j < 4; ++j) v[u][j] = xr[64 * j]; }
#pragma unroll
    for (int u = 0; u < UNR; ++u) { float ss = 0.f; const int row = row0 + u * rstride;
#pragma unroll
        for (int j = 0; j < 4; ++j) ss += (v[u][j].x * v[u][j].x + v[u][j].y * v[u][j].y) + (v[u][j].z * v[u][j].z + v[u][j].w * v[u][j].w);
        ss = wave_sum(ss);
        float r = 1.0f;
        if (NORM) r = 1.0f / sqrtf(ss * (1.f / D) + EPS);
        else if (lane < 16) stat[(size_t)row * 16 + lane] = (lane == 0) ? ss : 0.f;
        GAS v2u* o8 = (GAS v2u*)(o + (size_t)row * D) + lane;
#pragma unroll
        for (int j = 0; j < 4; ++j) o8[64 * j] = (v2u){pk2(v[u][j].x * r, v[u][j].y * r), pk2(v[u][j].z * r, v[u][j].w * r)}; }
}
template <bool NORM> __device__ __forceinline__ void rows_pass(const Frame& F, const float* x, bf16* o, float* stat, int nrows) {
    int m = F.gw;
    for (; m + 3 * F.NGW < nrows; m += 4 * F.NGW) rows_to_bf16<4, NORM>(x, o, stat, m, F.NGW, F.lane);
    for (; m < nrows; m += F.NGW) rows_to_bf16<1, NORM>(x, o, stat, m, F.NGW, F.lane);
}

constexpr int AL_K = 0, AL_KSZ = 12288, AL_V = 2 * AL_KSZ, AL_VSZ = 8192, AL_WS = AL_V + 2 * AL_VSZ, AL_OST = AL_WS + 8 * 256, AL_END = AL_OST + 8 * 4096;
static_assert(AL_END <= RING_BYTES, "attention LDS");
__device__ __forceinline__ int crow(int r, int hi) { return (r & 3) + 8 * (r >> 2) + 4 * hi; }
__device__ __forceinline__ unsigned cvtpk(float lo, float hi) { unsigned r; asm volatile("v_cvt_pk_bf16_f32 %0, %1, %2" : "=v"(r) : "v"(lo), "v"(hi)); return r; }

__device__ __forceinline__ float max3f(float a, float b, float c) { float r; asm("v_max3_f32 %0, %1, %2, %3" : "=v"(r) : "v"(a), "v"(b), "v"(c)); return r; }
__device__ __forceinline__ float max2f(float a, float b) { float r; asm("v_max_f32_e32 %0, %1, %2" : "=v"(r) : "v"(a), "v"(b)); return r; }
struct AttnWave {
    const bf16* Q; int ldq;
    bf16* O; int ldo;
    const bf16* K0; const bf16* K1; int ldk;
    const bf16* V; int ldv;
    int NT;
    int qpos0;
    float sink;
    const float* qgain; float qscale;
    const int* pos;
    unsigned* oflag;
    float kbound;
    float* st;
};
typedef float f32x2 __attribute__((ext_vector_type(2)));
typedef __bf16 bf16x2_t __attribute__((ext_vector_type(2)));
__device__ __forceinline__ unsigned cvtpk_m(float lo, float hi) { return __builtin_bit_cast(unsigned, __builtin_convertvector((f32x2){lo, hi}, bf16x2_t)); }
__device__ __forceinline__ f32x2 pk_add2(f32x2 a, f32x2 b) { f32x2 r; asm("v_pk_add_f32 %0, %1, %2" : "=v"(r) : "v"(a), "v"(b)); return r; }
__device__ __forceinline__ float wave_absmax(const float* g, int n, int lane) { float v = 0.f; for (int i = lane; i < n; i += 64) v = fmaxf(v, fabsf(g[i]));
    for (int o = 32; o > 0; o >>= 1) v = fmaxf(v, __shfl_xor(v, o)); return __builtin_bit_cast(float, __builtin_amdgcn_readfirstlane(__builtin_bit_cast(int, v))); }
template <int MASK> __device__ __forceinline__ bool att_active(int kt, int qpos0) {
    if (MASK == 1) return kt * 64 <= qpos0 + 31;
    if (MASK == 2) return (kt * 64 <= qpos0 + 31) && (kt * 64 + 63 > qpos0 - 128);
    return true;
}
template <int ND0> __device__ __forceinline__ void att_qk(const LAS unsigned char* kb, const bf16x8 (&qr)[ND0], f32x16& n0, f32x16& n1) {
    const f32x16 negm = {};
    bf16x8 kf[2 * ND0];
#pragma unroll
    for (int d0 = 0; d0 < ND0; ++d0) { kf[2 * d0] = *(const LAS bf16x8*)(kb + d0 * 2048); kf[2 * d0 + 1] = *(const LAS bf16x8*)(kb + d0 * 2048 + 512); }
    n0 = __builtin_amdgcn_mfma_f32_32x32x16_bf16(kf[0], qr[0], negm, 0, 0, 0); n1 = __builtin_amdgcn_mfma_f32_32x32x16_bf16(kf[1], qr[0], negm, 0, 0, 0);
#pragma unroll
    for (int d0 = 1; d0 < ND0; ++d0) {
        n0 = __builtin_amdgcn_mfma_f32_32x32x16_bf16(kf[2 * d0], qr[d0], n0, 0, 0, 0);
        n1 = __builtin_amdgcn_mfma_f32_32x32x16_bf16(kf[2 * d0 + 1], qr[d0], n1, 0, 0, 0); }
    asm volatile("s_nop 15\n\ts_nop 7" : "+v"(n0), "+v"(n1));
}
template <int ND0, int MASK, bool FUSED, bool NOREF>
__device__ __forceinline__ void att_body(const LAS unsigned char* kb, const LAS unsigned char* vb, const bf16x8 (&qr)[ND0], int kt, int qpos0, int r32, int hi, LAS float* wsf,
                                         f32x16& c0, f32x16& c1, f32x16& n0, f32x16& n1, f32x16& o0, f32x16& o1, float& m_run, float& l_run, bool& first) {
    constexpr int NDA = ND0 / 2, NDB = ND0 - NDA; const f32x16 negm = {};
    bf16x8 ka[2 * NDA], kq[2 * NDB];
    if constexpr (FUSED) {
#pragma unroll
        for (int d0 = 0; d0 < NDA; ++d0) { ka[2 * d0] = *(const LAS bf16x8*)(kb + d0 * 2048); ka[2 * d0 + 1] = *(const LAS bf16x8*)(kb + d0 * 2048 + 512); } }
    if (MASK != 0) {
        const int q = qpos0 + r32;
        bool need = (kt * 64 + 63 > qpos0);
        if (MASK == 2) need = need || (kt * 64 <= qpos0 + 31 - 128);
        if (need) {
#pragma unroll
            for (int r = 0; r < 16; ++r) { const int k0i = kt * 64 + crow(r, hi), k1i = k0i + 32;
                bool bad0 = k0i > q, bad1 = k1i > q;
                if (MASK == 2) { bad0 = bad0 || (k0i <= q - 128); bad1 = bad1 || (k1i <= q - 128); }
                if (bad0) c0[r] = -INFINITY; if (bad1) c1[r] = -INFINITY; }
        }
    }
    if constexpr (!NOREF) {
    float mx;
    { float a = max3f(c0[0], c0[1], c1[0]), b = max3f(c0[2], c0[3], c1[1]); a = max3f(a, c1[2], c1[3]);
#pragma unroll
      for (int r = 4; r < 16; r += 4) { a = max3f(a, c0[r], c0[r + 1]); b = max3f(b, c0[r + 2], c0[r + 3]); a = max3f(a, c1[r], c1[r + 1]); b = max3f(b, c1[r + 2], c1[r + 3]); }
      mx = max2f(a, b); mx = max2f(mx, __shfl_xor(mx, 32)) - m_run; }
    if (first || __any(mx > 8.0f)) {
        const float dl = (mx == -INFINITY) ? 0.f : (first ? mx : fmaxf(mx, 0.f));
        first = false;
        m_run += dl;
        const float alpha = __builtin_amdgcn_exp2f(-dl);
        l_run *= alpha;
        if (hi == 0) wsf[r32] = alpha;
        asm volatile("s_waitcnt lgkmcnt(0)" ::: "memory");
#pragma unroll
        for (int g = 0; g < 4; ++g) { const f32x4 a4 = *(const LAS f32x4*)(wsf + 8 * g + 4 * hi);
#pragma unroll
            for (int j = 0; j < 4; ++j) { o0[4 * g + j] *= a4[j]; o1[4 * g + j] *= a4[j]; } }
        asm volatile("" ::: "memory");
    }
    }
    const f32x2 nm2 = (f32x2){-m_run, -m_run}; (void)nm2;
    __builtin_amdgcn_sched_barrier(0);
    if constexpr (FUSED) {
        n0 = __builtin_amdgcn_mfma_f32_32x32x16_bf16(ka[0], qr[0], negm, 0, 0, 0); n1 = __builtin_amdgcn_mfma_f32_32x32x16_bf16(ka[1], qr[0], negm, 0, 0, 0);
#pragma unroll
        for (int d0 = 1; d0 < NDA; ++d0) {
            n0 = __builtin_amdgcn_mfma_f32_32x32x16_bf16(ka[2 * d0], qr[d0], n0, 0, 0, 0);
            n1 = __builtin_amdgcn_mfma_f32_32x32x16_bf16(ka[2 * d0 + 1], qr[d0], n1, 0, 0, 0); } }
#pragma unroll
    for (int r = 0; r < 16; r += 2) {
        if constexpr (NOREF) { c0[r] = __builtin_amdgcn_exp2f(c0[r]); c0[r + 1] = __builtin_amdgcn_exp2f(c0[r + 1]); }
        else { const f32x2 t2 = pk_add2((f32x2){c0[r], c0[r + 1]}, nm2); c0[r] = __builtin_amdgcn_exp2f(t2[0]); c0[r + 1] = __builtin_amdgcn_exp2f(t2[1]); }
        l_run += c0[r]; l_run += c0[r + 1]; }
    if constexpr (FUSED) {
#pragma unroll
        for (int d0 = 0; d0 < NDB; ++d0) { kq[2 * d0] = *(const LAS bf16x8*)(kb + (NDA + d0) * 2048); kq[2 * d0 + 1] = *(const LAS bf16x8*)(kb + (NDA + d0) * 2048 + 512); }
#define SGB_MT(n) __builtin_amdgcn_sched_group_barrier(0x008, 1, 0); __builtin_amdgcn_sched_group_barrier(0x400, n, 0);
        __builtin_amdgcn_sched_group_barrier(0x400, 4, 0);
        if constexpr (NDA == 3) { SGB_MT(2) SGB_MT(2) SGB_MT(2) SGB_MT(2) SGB_MT(2) SGB_MT(2) } else { SGB_MT(3) SGB_MT(3) SGB_MT(3) SGB_MT(3) }
        __builtin_amdgcn_sched_group_barrier(0x100, 2 * NDB, 0);
    }
    __builtin_amdgcn_sched_barrier(0);
    s16x4 vl[8], vh[8];
#pragma unroll
    for (int i = 0; i < 4; ++i) { const int off = i * 1024;
        vl[i] = __builtin_bit_cast(s16x4, __builtin_amdgcn_ds_read_tr16_b64_v4i16((LAS s16x4*)(vb + off)));
        vh[i] = __builtin_bit_cast(s16x4, __builtin_amdgcn_ds_read_tr16_b64_v4i16((LAS s16x4*)(vb + off + 512))); }
    if constexpr (FUSED) {
#pragma unroll
        for (int d0 = 0; d0 < NDB; ++d0) {
            n0 = __builtin_amdgcn_mfma_f32_32x32x16_bf16(kq[2 * d0], qr[NDA + d0], n0, 0, 0, 0);
            n1 = __builtin_amdgcn_mfma_f32_32x32x16_bf16(kq[2 * d0 + 1], qr[NDA + d0], n1, 0, 0, 0); } }
#pragma unroll
    for (int r = 0; r < 16; r += 2) {
        if constexpr (NOREF) { c1[r] = __builtin_amdgcn_exp2f(c1[r]); c1[r + 1] = __builtin_amdgcn_exp2f(c1[r + 1]); }
        else { const f32x2 t2 = pk_add2((f32x2){c1[r], c1[r + 1]}, nm2); c1[r] = __builtin_amdgcn_exp2f(t2[0]); c1[r + 1] = __builtin_amdgcn_exp2f(t2[1]); }
        l_run += c1[r]; l_run += c1[r + 1]; }
    if constexpr (FUSED) {
        __builtin_amdgcn_sched_group_barrier(0x100, 8, 0); __builtin_amdgcn_sched_group_barrier(0x400, 4, 0);
        if constexpr (NDB == 3) { SGB_MT(2) SGB_MT(2) SGB_MT(2) SGB_MT(2) SGB_MT(2) SGB_MT(2) } else { SGB_MT(3) SGB_MT(3) SGB_MT(3) SGB_MT(3) }
#undef SGB_MT
    }
    v4u pw[4];
    pw[0] = (v4u){cvtpk_m(c0[0], c0[1]), cvtpk_m(c0[2], c0[3]), cvtpk_m(c0[4], c0[5]), cvtpk_m(c0[6], c0[7])};
    pw[1] = (v4u){cvtpk_m(c0[8], c0[9]), cvtpk_m(c0[10], c0[11]), cvtpk_m(c0[12], c0[13]), cvtpk_m(c0[14], c0[15])};
    pw[2] = (v4u){cvtpk_m(c1[0], c1[1]), cvtpk_m(c1[2], c1[3]), cvtpk_m(c1[4], c1[5]), cvtpk_m(c1[6], c1[7])};
    pw[3] = (v4u){cvtpk_m(c1[8], c1[9]), cvtpk_m(c1[10], c1[11]), cvtpk_m(c1[12], c1[13]), cvtpk_m(c1[14], c1[15])};
    __builtin_amdgcn_sched_barrier(0);
#pragma unroll
    for (int i = 4; i < 8; ++i) { const int off = 4096 + (i & 3) * 1024;
        vl[i] = __builtin_bit_cast(s16x4, __builtin_amdgcn_ds_read_tr16_b64_v4i16((LAS s16x4*)(vb + off)));
        vh[i] = __builtin_bit_cast(s16x4, __builtin_amdgcn_ds_read_tr16_b64_v4i16((LAS s16x4*)(vb + off + 512))); }
#pragma unroll
    for (int ks = 0; ks < 4; ++ks) {
        const bf16x8 v0 = (bf16x8){vl[ks][0], vl[ks][1], vl[ks][2], vl[ks][3], vh[ks][0], vh[ks][1], vh[ks][2], vh[ks][3]};
        o0 = __builtin_amdgcn_mfma_f32_32x32x16_bf16(__builtin_bit_cast(bf16x8, pw[ks]), v0, o0, 0, 0, 0); }
#pragma unroll
    for (int ks = 0; ks < 4; ++ks) {
        const bf16x8 v1 = (bf16x8){vl[4 + ks][0], vl[4 + ks][1], vl[4 + ks][2], vl[4 + ks][3], vh[4 + ks][0], vh[4 + ks][1], vh[4 + ks][2], vh[4 + ks][3]};
        o1 = __builtin_amdgcn_mfma_f32_32x32x16_bf16(__builtin_bit_cast(bf16x8, pw[ks]), v1, o1, 0, 0, 0); }
}
template <int DQK, int MASK, bool QNORM, bool PUB, bool NOREF>
__device__ __forceinline__ void attn_unit(LAS unsigned char* lds, const AttnWave& W) {
    constexpr int ND0 = DQK / 16, NCH = DQK / 8;
    const int tid = tid_now(), lane = tid & 63, r32 = lane & 31, hi = lane >> 5; const int wid = __builtin_amdgcn_readfirstlane(tid >> 6);
    LAS float* wsf = (LAS float*)(lds + AL_WS) + wid * 64;
    bf16x8 qr[ND0];
#pragma unroll
    for (int d0 = 0; d0 < ND0; ++d0) qr[d0] = *(const GAS bf16x8*)(W.Q + (size_t)r32 * W.ldq + d0 * 16 + hi * 8);
    if constexpr (QNORM) {
        float qf[ND0][8]; float ss = 0.f;
#pragma unroll
        for (int d0 = 0; d0 < ND0; ++d0)
#pragma unroll
            for (int j = 0; j < 8; ++j) { qf[d0][j] = bf2f((unsigned short)qr[d0][j]); ss += qf[d0][j] * qf[d0][j]; }
        ss += __shfl_xor(ss, 32);
        const float r = __builtin_amdgcn_rsqf(ss * (1.0f / DQK) + EPS) * W.qscale;
#pragma unroll
        for (int d0 = 0; d0 < ND0; ++d0)
#pragma unroll
            for (int j = 0; j < 8; ++j) qf[d0][j] *= r * W.qgain[d0 * 16 + hi * 8 + j];
        if constexpr (DQK == 96) {
            const double p = (double)W.pos[r32];
#pragma unroll
            for (int j = 0; j < 8; ++j) { const int i = 8 * hi + j;
                const double rev = p * ((double)exp2f(-(float)i * (13.287712379549449f / 16.0f)) * 0.15915494309189535); const float fr = (float)(rev - __builtin_rint(rev));
                const float sn = __builtin_amdgcn_sinf(fr), cs = __builtin_amdgcn_cosf(fr);
                const float x1 = qf[4][j], x2 = qf[5][j]; qf[4][j] = x1 * cs - x2 * sn; qf[5][j] = x2 * cs + x1 * sn; } }
#pragma unroll
        for (int d0 = 0; d0 < ND0; ++d0) {
            v4u w;
            w.x = cvtpk(qf[d0][0], qf[d0][1]); w.y = cvtpk(qf[d0][2], qf[d0][3]); w.z = cvtpk(qf[d0][4], qf[d0][5]); w.w = cvtpk(qf[d0][6], qf[d0][7]);
            qr[d0] = __builtin_bit_cast(bf16x8, w); }
    }
    const int kc0 = wid, kc1 = wid + 8;
    const bool has2 = (kc1 < NCH);
    const bf16* ksrc0 = W.K0 + (size_t)lane * W.ldk + 8 * kc0;
    const bf16* ksrc1 = W.K1 + (size_t)lane * W.ldk + 8 * (kc1 - 8);
    const bf16* vsrc = W.V + (size_t)(16 * (wid & 3) + (lane >> 2)) * W.ldv + 32 * (wid >> 2) + 8 * (lane & 3);
    const size_t kstep = (size_t)64 * W.ldk, vstep = (size_t)64 * W.ldv;
    const int kdst0 = AL_K + kc0 * 1024 + lane * 16, kdst1 = AL_K + kc1 * 1024 + lane * 16, vdst = AL_V + wid * 1024 + lane * 16;
    const int kfrag = AL_K + hi * 1024 + r32 * 16;
    const int vfrag = AL_V + ((lane >> 4) & 1) * 32 + (lane & 3) * 8 + (4 * hi + ((lane & 15) >> 2)) * 64;
    v4u kreg0, kreg1 = (v4u){0u, 0u, 0u, 0u}, vreg;
    kreg0 = *(const GAS v4u*)ksrc0; if (has2) kreg1 = *(const GAS v4u*)ksrc1; vreg = *(const GAS v4u*)vsrc;
    *(LAS v4u*)(lds + kdst0) = kreg0; if (has2) *(LAS v4u*)(lds + kdst1) = kreg1; *(LAS v4u*)(lds + vdst) = vreg;
    kreg0 = *(const GAS v4u*)(ksrc0 + kstep); if (has2) kreg1 = *(const GAS v4u*)(ksrc1 + kstep);
    *(LAS v4u*)(lds + kdst0 + AL_KSZ) = kreg0; if (has2) *(LAS v4u*)(lds + kdst1 + AL_KSZ) = kreg1;
    __syncthreads();
    float m_run = 0.f, l_run = 0.f; f32x16 o0 = {}, o1 = {}; bool first = true;
    f32x16 sa0 = {}, sa1 = {}, sb0 = {}, sb1 = {};
    int t_hi = W.NT - 1, t_lo = 0;
    if (MASK != 0) { const int th = (W.qpos0 + 31) >> 6; t_hi = th < t_hi ? th : t_hi; }
    if (MASK == 2) { const int tl = (W.qpos0 - 127) >> 6; t_lo = tl > 0 ? tl : 0; }
    if (t_lo == 0) att_qk<ND0>(lds + kfrag, qr, sa0, sa1);
    asm volatile("s_waitcnt lgkmcnt(0)" ::: "memory");
    __syncthreads();
#define ATT_LOADS(KT) const int kt_ = (KT); const int buf_ = kt_ & 1;                                                                                   \
               \
        const bool more1_ = (MASK == 1) || (kt_ + 1 < W.NT), more2_ = (MASK == 1) || (kt_ + 2 < W.NT);                                              \
        const int k2_ = (MASK == 1) ? (kt_ + 2 < W.NT ? kt_ + 2 : W.NT - 1) : kt_ + 2, v1_ = (MASK == 1) ? (kt_ + 1 < W.NT ? kt_ + 1 : W.NT - 1) : kt_ + 1; \
        if (more2_) { kreg0 = *(const GAS v4u*)(ksrc0 + (size_t)k2_ * kstep); if (has2) kreg1 = *(const GAS v4u*)(ksrc1 + (size_t)k2_ * kstep); }   \
        if (more1_) vreg = *(const GAS v4u*)(vsrc + (size_t)v1_ * vstep);                                                                           \
        const LAS unsigned char* kb_ = lds + kfrag + (buf_ ^ 1) * AL_KSZ; const LAS unsigned char* vb_ = lds + vfrag + buf_ * AL_VSZ; (void)kb_; (void)vb_;
#define ATT_STORES()                                                                                                                                \
        if (more2_) { *(LAS v4u*)(lds + kdst0 + buf_ * AL_KSZ) = kreg0; if (has2) *(LAS v4u*)(lds + kdst1 + buf_ * AL_KSZ) = kreg1; }               \
        if (more1_) *(LAS v4u*)(lds + vdst + (buf_ ^ 1) * AL_VSZ) = vreg;                                                                           \
        __syncthreads();
#define ATT_FUSED(KT, C0, C1, N0, N1) do { ATT_LOADS(KT)                                                                                            \
        att_body<ND0, MASK, true, NOREF>(kb_, vb_, qr, kt_, W.qpos0, r32, hi, wsf, C0, C1, N0, N1, o0, o1, m_run, l_run, first);              \
        ATT_STORES() } while (0)
    int kt = 0;
#pragma unroll 1
    for (; kt < t_lo; ++kt) { ATT_LOADS(kt) if (kt_ == t_lo - 1) att_qk<ND0>(kb_, qr, sa0, sa1); ATT_STORES() }
#pragma unroll 1
    for (; kt + 1 < t_hi; kt += 2) { ATT_FUSED(kt, sa0, sa1, sb0, sb1); ATT_FUSED(kt + 1, sb0, sb1, sa0, sa1); }
    if (kt < t_hi) { ATT_FUSED(kt, sa0, sa1, sb0, sb1); sa0 = sb0; sa1 = sb1; ++kt; }
    { ATT_LOADS(kt) att_body<ND0, MASK, false, NOREF>(kb_, vb_, qr, kt_, W.qpos0, r32, hi, wsf, sa0, sa1, sb0, sb1, o0, o1, m_run, l_run, first); ATT_STORES() }
    ++kt;
#pragma unroll 1
    for (; kt < W.NT; ++kt) { ATT_LOADS(kt) ATT_STORES() }
#undef ATT_FUSED
#undef ATT_STORES
#undef ATT_LOADS
    l_run += __shfl_xor(l_run, 32);
    if (W.sink > -INFINITY) l_run += __builtin_amdgcn_exp2f(W.sink - m_run);
    if (hi == 0) wsf[32 + r32] = __builtin_amdgcn_rcpf(l_run);
    asm volatile("s_waitcnt lgkmcnt(0)" ::: "memory");
    LAS bf16* stg = (LAS bf16*)(lds + AL_OST) + wid * 2048;
#pragma unroll
    for (int g = 0; g < 4; ++g) { const f32x4 a4 = *(const LAS f32x4*)(wsf + 32 + 8 * g + 4 * hi);
#pragma unroll
        for (int j = 0; j < 4; ++j) { const int orow = 8 * g + 4 * hi + j;
            stg[orow * 64 + r32] = (bf16)f2bf(o0[4 * g + j] * a4[j]); stg[orow * 64 + 32 + r32] = (bf16)f2bf(o1[4 * g + j] * a4[j]); } }
    asm volatile("s_waitcnt lgkmcnt(0)" ::: "memory");
#pragma unroll
    for (int i = 0; i < 4; ++i) { const int row = i * 8 + (lane >> 3), ch = lane & 7; const v4u v = *(const LAS v4u*)(stg + row * 64 + ch * 8); if constexpr (PUB) pg8::st_wt16(W.O + (size_t)row * W.ldo + ch * 8, v); else *(GAS v4u*)(W.O + (size_t)row * W.ldo + ch * 8) = v;
        if (W.st) { float ss = bflo(v.x) * bflo(v.x) + bfhi(v.x) * bfhi(v.x) + bflo(v.y) * bflo(v.y) + bfhi(v.y) * bfhi(v.y) + bflo(v.z) * bflo(v.z) + bfhi(v.z) * bfhi(v.z) + bflo(v.w) * bflo(v.w) + bfhi(v.w) * bfhi(v.w);
            ss += __shfl_xor(ss, 1); ss += __shfl_xor(ss, 2); ss += __shfl_xor(ss, 4);
            if (ch == 0) W.st[4 * row] = ss; } }
    if constexpr (PUB) pg8::flag_arrive(W.oflag, lane);
    __syncthreads();
}

struct T3Const { float gqv[6], gkv[6], sgqv[4], sgkv[4], cwv[3][4], cbv[4]; double invf; };
template <int UNR, int PART> __device__ __forceinline__ void t3_tokens(const Frame& F, const T3Const& C, int t0, int tstride, bool dry) {
    const int lane = F.lane, h = lane >> 4, sub = lane & 15, kh = h & 1;
    bf16* U = (bf16*)(F.ws + WS_U); bf16* QKV = (bf16*)(F.ws + WS_QKV); bf16* Y = (bf16*)(F.ws + WS_Y);
    const int* positions = (const int*)ARGP(2);
    const int c0 = 4 * lane, pg = lane >> 4, pw = 2 << pg;
    unsigned short kv[UNR][6], sk[UNR][4]; v2u pl[UNR][16], cc[UNR][3], chh[UNR][3], cbg[UNR]; int pos[UNR];
#pragma unroll
    for (int u = 0; u < UNR; ++u) { const int t = t0 + u * tstride, s = t & (SEQ - 1);
        const bf16* qrow = QKV + (size_t)t * 1024; const bf16* urow = U + (size_t)t * UW;
        if (PART == 0) {
        pos[u] = positions[t];
#pragma unroll
        for (int j = 0; j < 4; ++j) kv[u][j] = qrow[QC_KV + 128 * h + sub + 16 * j];
        kv[u][4] = urow[UC_ROPE + sub]; kv[u][5] = urow[UC_ROPE + 16 + sub];
#pragma unroll
        for (int j = 0; j < 4; ++j) sk[u][j] = urow[UC_SK + 64 * kh + sub + 16 * j];
        } else {
#pragma unroll
        for (int tau = 0; tau < 16; ++tau) { const int back = (tau < s) ? tau : s; pl[u][tau] = *(const GAS v2u*)(urow - (size_t)back * UW + UC_POOL + c0); }
#pragma unroll
        for (int tau = 0; tau < 3; ++tau) { const int back = (tau < s) ? tau : s; cc[u][tau] = *(const GAS v2u*)(urow - (size_t)back * UW + UC_CC + c0); chh[u][tau] = *(const GAS v2u*)(urow - (size_t)back * UW + UC_CH + c0); }
        cbg[u] = *(const GAS v2u*)(urow + UC_CB + c0);
        }
    }
#pragma unroll
    for (int u = 0; u < UNR; ++u) { const int t = t0 + u * tstride, s = t & (SEQ - 1);
        bf16* qrow = QKV + (size_t)t * 1024; bf16* urow = U + (size_t)t * UW;
        if (PART == 0) {
        const double rev = (double)pos[u] * C.invf; const float fr = (float)(rev - __builtin_rint(rev));
        const float sn = __builtin_amdgcn_sinf(fr), cs = __builtin_amdgcn_cosf(fr);
        {
            float v[6]; float ss = 0.f;
#pragma unroll
            for (int j = 0; j < 6; ++j) { v[j] = bf2f(kv[u][j]); ss += v[j] * v[j]; }
            const float r = __builtin_amdgcn_rsqf(sum16(ss) * (1.0f / 96.0f) + EPS);
#pragma unroll
            for (int j = 0; j < 6; ++j) v[j] *= r * C.gkv[j];
            const float x1 = v[4], x2 = v[5]; v[4] = x1 * cs - x2 * sn; v[5] = x2 * cs + x1 * sn;
#pragma unroll
            for (int j = 0; j < 4; ++j) qrow[QC_KV + 128 * h + sub + 16 * j] = dry ? kv[u][j] : (bf16)f2bf(v[j]);
            if (!dry) { qrow[QC_KR + 32 * h + sub] = (bf16)f2bf(v[4]); qrow[QC_KR + 32 * h + 16 + sub] = (bf16)f2bf(v[5]); }
        }
        {
            float v[4]; float ss = 0.f;
#pragma unroll
            for (int j = 0; j < 4; ++j) { v[j] = bf2f(sk[u][j]); ss += v[j] * v[j]; }
            const float rk = __builtin_amdgcn_rsqf(sum16(ss) * (1.0f / 64.0f) + EPS);
            if (lane < 32) {
#pragma unroll
                for (int j = 0; j < 4; ++j) urow[UC_SK + 64 * kh + sub + 16 * j] = dry ? sk[u][j] : (bf16)f2bf(v[j] * rk * C.sgkv[j]); }
        }
        } else {
        {
            const int cnt = (s + 1 < pw) ? (s + 1) : pw;
            float a[4] = {0.f, 0.f, 0.f, 0.f};
#pragma unroll
            for (int tau = 0; tau < 16; ++tau) { const float m = (tau < cnt) ? 1.0f : 0.0f; const v2u w = pl[u][tau];
                a[0] += m * bflo(w.x); a[1] += m * bfhi(w.x); a[2] += m * bflo(w.y); a[3] += m * bfhi(w.y); }
            const float u0[4] = {bflo(pl[u][0].x), bfhi(pl[u][0].x), bflo(pl[u][0].y), bfhi(pl[u][0].y)};
            const float ic = 1.0f / (float)cnt; float ss = 0.f;
#pragma unroll
            for (int j = 0; j < 4; ++j) { a[j] = a[j] * ic - u0[j]; ss += a[j] * a[j]; }
            const float r = __builtin_amdgcn_rsqf(wave_sum(ss) * (1.0f / 256.0f) + EPS);
            *(GAS v2u*)(Y + (size_t)t * 1024 + 512 + c0) = (v2u){pk2(a[0] * r, a[1] * r), pk2(a[2] * r, a[3] * r)};
        }
        {
            float z[3][4];
#pragma unroll
            for (int tau = 0; tau < 3; ++tau) { const float m = (s - tau >= 0) ? 1.0f : 0.0f; const v2u wc = cc[u][tau], wh = chh[u][tau];
                z[tau][0] = m * bflo(wc.x) * bflo(wh.x); z[tau][1] = m * bfhi(wc.x) * bfhi(wh.x); z[tau][2] = m * bflo(wc.y) * bflo(wh.y); z[tau][3] = m * bfhi(wc.y) * bfhi(wh.y); }
            const v2u wb = cbg[u]; const float bg[4] = {bflo(wb.x), bfhi(wb.x), bflo(wb.y), bfhi(wb.y)};
            float y[4]; float ss = 0.f;
#pragma unroll
            for (int j = 0; j < 4; ++j) { y[j] = bg[j] * (C.cwv[0][j] * z[2][j] + C.cwv[1][j] * z[1][j] + C.cwv[2][j] * z[0][j] + C.cbv[j]); ss += y[j] * y[j]; }
            const float r = __builtin_amdgcn_rsqf(wave_sum(ss) * (1.0f / 256.0f) + EPS);
            *(GAS v2u*)(Y + (size_t)t * 1024 + 768 + c0) = (v2u){pk2(y[0] * r, y[1] * r), pk2(y[2] * r, y[3] * r)};
        }
        }
    }
}
template <int UNR> __device__ __forceinline__ void t3_k_tokens(const Frame& F, const T3Const& C, int t0, int tstride, bool dry) {
    const int lane = F.lane, h = lane >> 4, sub = lane & 15, kh = h & 1;
    bf16* U = (bf16*)(F.ws + WS_U); bf16* QKV = (bf16*)(F.ws + WS_QKV);
    const int* positions = (const int*)ARGP(2);
    v2u kn[UNR], sk[UNR]; unsigned short kr[UNR][2]; int pos[UNR];
#pragma unroll
    for (int u = 0; u < UNR; ++u) { const int t = t0 + u * tstride;
        const bf16* qrow = QKV + (size_t)t * 1024; const bf16* urow = U + (size_t)t * UW;
        pos[u] = positions[t];
        kn[u] = *(const GAS v2u*)(qrow + QC_KV + 128 * h + 4 * sub);
        kr[u][0] = urow[UC_ROPE + sub]; kr[u][1] = urow[UC_ROPE + 16 + sub];
        sk[u] = *(const GAS v2u*)(urow + UC_SK + 64 * kh + 4 * sub); }
#pragma unroll
    for (int u = 0; u < UNR; ++u) { const int t = t0 + u * tstride;
        bf16* qrow = QKV + (size_t)t * 1024; bf16* urow = U + (size_t)t * UW;
        const double rev = (double)pos[u] * C.invf; const float fr = (float)(rev - __builtin_rint(rev));
        const float sn = __builtin_amdgcn_sinf(fr), cs = __builtin_amdgcn_cosf(fr);
        {
            float v[6] = {bflo(kn[u].x), bfhi(kn[u].x), bflo(kn[u].y), bfhi(kn[u].y), bf2f(kr[u][0]), bf2f(kr[u][1])}; float ss = 0.f;
#pragma unroll
            for (int j = 0; j < 6; ++j) ss += v[j] * v[j];
            const float r = __builtin_amdgcn_rsqf(sum16(ss) * (1.0f / 96.0f) + EPS);
#pragma unroll
            for (int j = 0; j < 6; ++j) v[j] *= r * C.gkv[j];
            const float x1 = v[4], x2 = v[5]; v[4] = x1 * cs - x2 * sn; v[5] = x2 * cs + x1 * sn;
            *(GAS v2u*)(qrow + QC_KV + 128 * h + 4 * sub) = dry ? kn[u] : (v2u){pk2(v[0], v[1]), pk2(v[2], v[3])};
            if (!dry) { qrow[QC_KR + 32 * h + sub] = (bf16)f2bf(v[4]); qrow[QC_KR + 32 * h + 16 + sub] = (bf16)f2bf(v[5]); }
        }
        {
            const float v[4] = {bflo(sk[u].x), bfhi(sk[u].x), bflo(sk[u].y), bfhi(sk[u].y)}; float ss = 0.f;
#pragma unroll
            for (int j = 0; j < 4; ++j) ss += v[j] * v[j];
            const float rk = __builtin_amdgcn_rsqf(sum16(ss) * (1.0f / 64.0f) + EPS);
            if (lane < 32) *(GAS v2u*)(urow + UC_SK + 64 * kh + 4 * sub) = dry ? sk[u] : (v2u){pk2(v[0] * rk * C.sgkv[0], v[1] * rk * C.sgkv[1]), pk2(v[2] * rk * C.sgkv[2], v[3] * rk * C.sgkv[3])};
        }
    }
}
template <int R> __device__ __forceinline__ void t3_run(const Frame& F, const T3Const& C, int t0) {
    const int lane = F.lane, c0 = 4 * lane, pg = lane >> 4, pw = 2 << pg;
    const bf16* U = (const bf16*)(F.ws + WS_U); bf16* Y = (bf16*)(F.ws + WS_Y);
    const int s0 = t0 & (SEQ - 1);
    const bf16* base = U + (size_t)t0 * UW + c0;
    v2u pl[R + 15], cc[R + 2], chh[R + 2], cbg[R];
#pragma unroll
    for (int i = 0; i < R + 15; ++i) { const int off = i - 15; const int o2 = (off < -s0) ? -s0 : off; pl[i] = *(const GAS v2u*)(base + (ptrdiff_t)o2 * UW + UC_POOL); }
#pragma unroll
    for (int i = 0; i < R + 2; ++i) { const int off = i - 2; const int o2 = (off < -s0) ? -s0 : off; cc[i] = *(const GAS v2u*)(base + (ptrdiff_t)o2 * UW + UC_CC); chh[i] = *(const GAS v2u*)(base + (ptrdiff_t)o2 * UW + UC_CH); }
#pragma unroll
    for (int u = 0; u < R; ++u) cbg[u] = *(const GAS v2u*)(base + (size_t)u * UW + UC_CB);
#pragma unroll
    for (int u = 0; u < R; ++u) { const int t = t0 + u, s = s0 + u;
        {
            const int cnt = (s + 1 < pw) ? (s + 1) : pw;
            float a[4] = {0.f, 0.f, 0.f, 0.f};
#pragma unroll
            for (int tau = 0; tau < 16; ++tau) { const float m = (tau < cnt) ? 1.0f : 0.0f; const v2u w = pl[15 + u - tau];
                a[0] += m * bflo(w.x); a[1] += m * bfhi(w.x); a[2] += m * bflo(w.y); a[3] += m * bfhi(w.y); }
            const v2u w0 = pl[15 + u]; const float u0[4] = {bflo(w0.x), bfhi(w0.x), bflo(w0.y), bfhi(w0.y)};
            const float ic = 1.0f / (float)cnt; float ss = 0.f;
#pragma unroll
            for (int j = 0; j < 4; ++j) { a[j] = a[j] * ic - u0[j]; ss += a[j] * a[j]; }
            const float r = __builtin_amdgcn_rsqf(wave_sum(ss) * (1.0f / 256.0f) + EPS);
            *(GAS v2u*)(Y + (size_t)t * 1024 + 512 + c0) = (v2u){pk2(a[0] * r, a[1] * r), pk2(a[2] * r, a[3] * r)};
        }
        {
            float z[3][4];
#pragma unroll
            for (int tau = 0; tau < 3; ++tau) { const float m = (s - tau >= 0) ? 1.0f : 0.0f; const v2u wc = cc[u + 2 - tau], wh = chh[u + 2 - tau];
                z[tau][0] = m * bflo(wc.x) * bflo(wh.x); z[tau][1] = m * bfhi(wc.x) * bfhi(wh.x); z[tau][2] = m * bflo(wc.y) * bflo(wh.y); z[tau][3] = m * bfhi(wc.y) * bfhi(wh.y); }
            const v2u wb = cbg[u]; const float bg[4] = {bflo(wb.x), bfhi(wb.x), bflo(wb.y), bfhi(wb.y)};
            float y[4]; float ss = 0.f;
#pragma unroll
            for (int j = 0; j < 4; ++j) { y[j] = bg[j] * (C.cwv[0][j] * z[2][j] + C.cwv[1][j] * z[1][j] + C.cwv[2][j] * z[0][j] + C.cbv[j]); ss += y[j] * y[j]; }
            const float r = __builtin_amdgcn_rsqf(wave_sum(ss) * (1.0f / 256.0f) + EPS);
            *(GAS v2u*)(Y + (size_t)t * 1024 + 768 + c0) = (v2u){pk2(y[0] * r, y[1] * r), pk2(y[2] * r, y[3] * r)};
        }
    }
}
__device__ __forceinline__ void t3_pass(const Frame& F, int l, bool dry) {
    const int lane = F.lane, sub = lane & 15, c0 = 4 * lane;
    const float* gq = (const float*)ARGP(9) + l * 96; const float* gk = (const float*)ARGP(10) + l * 96;
    const float* sgq = (const float*)ARGP(13) + l * 64; const float* sgk = (const float*)ARGP(14) + l * 64;
    const float* cw = (const float*)ARGP(16) + l * 3 * 256; const float* cb = (const float*)ARGP(17) + l * 256;
    T3Const C;
#pragma unroll
    for (int j = 0; j < 6; ++j) { C.gqv[j] = gq[sub + 16 * j]; C.gkv[j] = (j < 4) ? gk[4 * sub + j] : gk[sub + 16 * j]; }
#pragma unroll
    for (int j = 0; j < 4; ++j) { C.sgqv[j] = sgq[sub + 16 * j]; C.sgkv[j] = sgk[4 * sub + j]; }
#pragma unroll
    for (int j = 0; j < 4; ++j) { C.cwv[0][j] = cw[c0 + j]; C.cwv[1][j] = cw[256 + c0 + j]; C.cwv[2][j] = cw[512 + c0 + j]; C.cbv[j] = cb[c0 + j]; }
    C.invf = (double)exp2f(-(float)sub * (13.287712379549449f / 16.0f)) * 0.15915494309189535;
    int t = F.gw;
    for (; t + 7 * F.NGW < M; t += 8 * F.NGW) t3_k_tokens<8>(F, C, t, F.NGW, dry);
    for (; t < M; t += F.NGW) t3_k_tokens<1>(F, C, t, F.NGW, dry);
    for (int run = F.gw; run < M / 4; run += F.NGW) t3_run<4>(F, C, 4 * run);
}
template <int UNR> __device__ __forceinline__ void t5_tokens(bf16* Y, int t0, int tstride, int col) {
    v4u w[UNR];
#pragma unroll
    for (int u = 0; u < UNR; ++u) w[u] = *(const GAS v4u*)(Y + (size_t)(t0 + u * tstride) * 1024 + col);
#pragma unroll
    for (int u = 0; u < UNR; ++u) {
        float v[8] = {bflo(w[u].x), bfhi(w[u].x), bflo(w[u].y), bfhi(w[u].y), bflo(w[u].z), bfhi(w[u].z), bflo(w[u].w), bfhi(w[u].w)}; float ss = 0.f;
#pragma unroll
        for (int j = 0; j < 8; ++j) ss += v[j] * v[j];
        const float r = __builtin_amdgcn_rsqf(sum32(ss) * (1.0f / 256.0f) + EPS);
        *(GAS v4u*)(Y + (size_t)(t0 + u * tstride) * 1024 + col) = (v4u){pk2(v[0] * r, v[1] * r), pk2(v[2] * r, v[3] * r), pk2(v[4] * r, v[5] * r), pk2(v[6] * r, v[7] * r)}; }
}
__device__ __forceinline__ void t5_pass(const Frame& F) {
    bf16* Y = (bf16*)(F.ws + WS_Y); const int lane = F.lane; const int col = (lane < 32) ? 8 * lane : 512 + 8 * (lane - 32);
    int t = F.gw;
    for (; t + 7 * F.NGW < M; t += 8 * F.NGW) t5_tokens<8>(Y, t, F.NGW, col);
    for (; t < M; t += F.NGW) t5_tokens<1>(Y, t, F.NGW, col);
}
__device__ __forceinline__ void kx_norm_pass(const Frame& F) {
    bf16* KV = (bf16*)(F.ws + WS_KVX); const int lane = F.lane, h = lane >> 4, sub = lane & 15;
    for (int it = F.gw; it < MM * NL; it += F.NGW) { const int row = it >> 1, l = it & 1; const float* g = (const float*)ARGP(25) + l * 64;
        bf16* p = KV + (size_t)row * 1024 + 512 * l + 64 * h; float v[4]; float ss = 0.f;
#pragma unroll
        for (int j = 0; j < 4; ++j) { v[j] = bf2f(p[sub + 16 * j]); ss += v[j] * v[j]; }
        const float r = __builtin_amdgcn_rsqf(sum16(ss) * (1.0f / 64.0f) + EPS);
#pragma unroll
        for (int j = 0; j < 4; ++j) p[sub + 16 * j] = (bf16)f2bf(v[j] * r * g[sub + 16 * j]); }
}

__device__ __forceinline__ void route_pass(const Frame& F, int l) {
    int* EID = (int*)(F.ws + WS_EID); int* RANK = (int*)(F.ws + WS_SLOT); int* CNT = (int*)(F.ws + WS_CTL) + CW_CNT + 2048 * l;
    int* TOKR = (int*)(F.ws + WS_TOKR); float* RSR = (float*)(F.ws + WS_RSR); float* WR = (float*)(F.ws + WS_WR);
    const float* STX = (const float*)(F.ws + WS_STX); const bf16* XB = (const bf16*)(F.ws + WS_XB);
    const bf16* BR = (const bf16*)(F.ws + WS_W + (size_t)l * 57 * MiB + WL_R);
    const float* bg = (const float*)ARGP(29) + l * 4; const float* be = (const float*)ARGP(31) + l * 32;
    LAS int* lh = (LAS int*)(F.lds + RING_OFF);
    LAS float* llog = (LAS float*)(F.lds + RING_OFF + 1024);
    LAS int* lbase = lh + 32;
    const int lane = F.lane, fr = lane & 15, fq = lane >> 4;
    for (int ch = F.bx; ch < M / 128; ch += F.G) {
        if (F.tid < 32) lh[F.tid] = 0;
        float rn_pre = 0.f;
        if (F.tid < 128) { const int t = ch * 128 + F.tid; float ss = 0.f;
#pragma unroll
            for (int i = 0; i < 16; i += 4) { const f32x4 p4 = *(const GAS f32x4*)(STX + (size_t)t * 16 + i); ss += (p4[0] + p4[1]) + (p4[2] + p4[3]); }
            rn_pre = __builtin_amdgcn_rsqf(ss * (1.0f / D) + EPS); }
        {
            const bf16* ap = XB + (size_t)(ch * 128 + 16 * F.wave + fr) * D + 8 * fq;
            LAS unsigned char* lb = (LAS unsigned char*)F.lds + RING_OFF + 32768;
            bf16x8 a[32];
#pragma unroll
            for (int i = 0; i < 32; ++i) a[i] = *(const GAS bf16x8*)(ap + 32 * i);
            f32x4 acc0 = {0.f, 0.f, 0.f, 0.f}, acc1 = acc0, acc2 = acc0;
#pragma unroll
            for (int q = 0; q < 4; ++q) {
                if (q) __syncthreads();
#pragma unroll
                for (int j = 0; j < 3; ++j) { const int p = F.tid + NTHR * j, row = p >> 5, c = p & 31; *(LAS v4u*)(lb + row * 528 + c * 16) = *(const GAS v4u*)(BR + (size_t)row * D + 256 * q + 8 * c); }
                __syncthreads();
#pragma unroll
                for (int i = 0; i < 8; ++i) { const LAS unsigned char* bq = lb + fr * 528 + 64 * i + 16 * fq;
                    const bf16x8 b0 = *(const LAS bf16x8*)bq, b1 = *(const LAS bf16x8*)(bq + 16 * 528), b2 = *(const LAS bf16x8*)(bq + 32 * 528);
                    acc0 = __builtin_amdgcn_mfma_f32_16x16x32_bf16(a[8 * q + i], b0, acc0, 0, 0, 0); acc1 = __builtin_amdgcn_mfma_f32_16x16x32_bf16(a[8 * q + i], b1, acc1, 0, 0, 0); acc2 = __builtin_amdgcn_mfma_f32_16x16x32_bf16(a[8 * q + i], b2, acc2, 0, 0, 0); } }
#pragma unroll
            for (int r = 0; r < 4; ++r) { LAS float* row = llog + (16 * F.wave + 4 * fq + r) * 52; row[fr] = acc0[r]; row[16 + fr] = acc1[r]; row[32 + fr] = acc2[r]; } }
        __syncthreads();
        if (F.wave >= 2 && ch == F.bx) prep_experts<1>(F, l, F.bx * 6 + (F.wave - 2), F.G * 6);
        int re1 = 0, re2 = 0, rr1 = 0, rr2 = 0; float rw1 = 0.f, rw2 = 0.f, rrn = 0.f;
        if (F.tid < 128) { const int t = ch * 128 + F.tid; const LAS float* lr = llog + F.tid * 52;
            const float rn = rn_pre;
            float g[4]; int gi = 0;
#pragma unroll
            for (int j = 0; j < 4; ++j) g[j] = lr[j] * rn + bg[j];
#pragma unroll
            for (int j = 1; j < 4; ++j) if (g[j] > g[gi]) gi = j;
            float gs = 0.f;
#pragma unroll
            for (int j = 0; j < 4; ++j) gs += __expf(g[j] - g[gi]);
            const float gw = 1.0f / gs;
            float e[8];
#pragma unroll
            for (int j = 0; j < 8; ++j) e[j] = lr[4 + 8 * gi + j] * rn + be[8 * gi + j];
            int i1 = 0;
#pragma unroll
            for (int j = 1; j < 8; ++j) if (e[j] > e[i1]) i1 = j;
            int i2 = (i1 == 0) ? 1 : 0;
#pragma unroll
            for (int j = 0; j < 8; ++j) if (j != i1 && e[j] > e[i2]) i2 = j;
            const float d = __expf(e[i2] - e[i1]);
            const float w1 = gw / (1.0f + d), w2 = gw * d / (1.0f + d);
            const int e1 = 8 * gi + i1, e2 = 8 * gi + i2;
            EID[2 * t] = e1; EID[2 * t + 1] = e2;
            re1 = e1; re2 = e2; rw1 = w1; rw2 = w2; rrn = rn;
            rr1 = atomicAdd((int*)&lh[e1], 1); rr2 = atomicAdd((int*)&lh[e2], 1); }
        __syncthreads();
        if (F.tid < 32) lbase[F.tid] = (lh[F.tid] > 0) ? atomicAdd(&CNT[64 * F.tid], lh[F.tid]) : 0;
        __syncthreads();
        if (F.tid < 128) { const int t = ch * 128 + F.tid; const int k1 = lbase[re1] + rr1, k2 = lbase[re2] + rr2;
            TOKR[(size_t)re1 * ECAP + k1] = t; RSR[(size_t)re1 * ECAP + k1] = rrn; WR[(size_t)re1 * ECAP + k1] = rw1; RANK[2 * t] = k1;
            TOKR[(size_t)re2 * ECAP + k2] = t; RSR[(size_t)re2 * ECAP + k2] = rrn; WR[(size_t)re2 * ECAP + k2] = rw2; RANK[2 * t + 1] = k2; }
        __syncthreads();
    }
}
__device__ __forceinline__ int shfl_up_l(int v, int o, int lane_l) { return __builtin_amdgcn_ds_bpermute(((lane_l - o) & 63) << 2, v); }
__device__ __forceinline__ int moe_tables(const Frame& F, int l, LAS int* cnt, LAS int* pblk, LAS int* bexp) {
    const int* CNT = (const int*)(F.ws + WS_CTL) + CW_CNT + 2048 * l;
    if (F.tid < 64) { const int e = F.tid & 31; const int c = CNT[64 * e]; const int nb = (F.tid < 32) ? ((c + 255) >> 8) : 0; int inc = nb;
        int ll = F.tid; asm volatile("" : "+v"(ll));
#pragma unroll
        for (int o = 1; o < 32; o <<= 1) { const int v = shfl_up_l(inc, o, ll); if ((ll & 31) >= o) inc += v; }
        if (F.tid < 32) { cnt[e] = c; const int pb = inc - nb; pblk[e] = pb; for (int j = 0; j < nb; ++j) bexp[pb + j] = e; if (e == 31) pblk[32] = inc; } }
    __syncthreads();
    return pblk[32];
}
template <int UNR> __device__ __forceinline__ void combine_tokens(const Frame& F, int l, int t0, int tstride, float ysc, int pstart) {
    typedef float f32x2 __attribute__((ext_vector_type(2)));
    const int* RANK = (const int*)(F.ws + WS_SLOT); const int* EID = (const int*)(F.ws + WS_EID); const unsigned char* YB = (const unsigned char*)(F.ws + WS_YB); bf16* XB = (bf16*)(F.ws + WS_XB); float* STX = (float*)(F.ws + WS_STX);
    int s0[UNR], s1[UNR];
#pragma unroll
    for (int u = 0; u < UNR; ++u) { const int t = t0 + u * tstride;
        s0[u] = __shfl(pstart, EID[2 * t]) + RANK[2 * t]; s1[u] = __shfl(pstart, EID[2 * t + 1]) + RANK[2 * t + 1]; }
    v4u xv[UNR][2], a[UNR], b[UNR];
#pragma unroll
    for (int u = 0; u < UNR; ++u) { const int t = t0 + u * tstride;
        const GAS v4u* xr = (const GAS v4u*)(XB + (size_t)t * D) + 2 * F.lane;
        xv[u][0] = xr[0]; xv[u][1] = xr[1];
        a[u] = *((const GAS v4u*)(YB + (size_t)s0[u] * D) + F.lane); b[u] = *((const GAS v4u*)(YB + (size_t)s1[u] * D) + F.lane); }
#pragma unroll
    for (int u = 0; u < UNR; ++u) { const int t = t0 + u * tstride; float ss = 0.f; float x[16];
#pragma unroll
        for (int q = 0; q < 4; ++q) {
            const f32x2 a01 = __builtin_amdgcn_cvt_pk_f32_fp8((int)a[u][q], false), a23 = __builtin_amdgcn_cvt_pk_f32_fp8((int)a[u][q], true);
            const f32x2 b01 = __builtin_amdgcn_cvt_pk_f32_fp8((int)b[u][q], false), b23 = __builtin_amdgcn_cvt_pk_f32_fp8((int)b[u][q], true);
            const unsigned xw0 = xv[u][q >> 1][2 * (q & 1)], xw1 = xv[u][q >> 1][2 * (q & 1) + 1];
            x[4 * q] = bflo(xw0) + ysc * (a01.x + b01.x); x[4 * q + 1] = bfhi(xw0) + ysc * (a01.y + b01.y);
            x[4 * q + 2] = bflo(xw1) + ysc * (a23.x + b23.x); x[4 * q + 3] = bfhi(xw1) + ysc * (a23.y + b23.y); }
#pragma unroll
        for (int q = 0; q < 16; ++q) ss += x[q] * x[q];
        if (l == 0) { GAS v4u* xo = (GAS v4u*)(XB + (size_t)t * D) + 2 * F.lane;
            xo[0] = (v4u){pk2(x[0], x[1]), pk2(x[2], x[3]), pk2(x[4], x[5]), pk2(x[6], x[7])}; xo[1] = (v4u){pk2(x[8], x[9]), pk2(x[10], x[11]), pk2(x[12], x[13]), pk2(x[14], x[15])};
            ss = wave_sum(ss); if (F.lane < 16) STX[(size_t)t * 16 + F.lane] = (F.lane == 0) ? ss : 0.f; }
        else { GAS f32x4* o = (GAS f32x4*)(F.X + (size_t)t * D) + 4 * F.lane;
#pragma unroll
            for (int q = 0; q < 4; ++q) o[q] = (f32x4){x[4 * q], x[4 * q + 1], x[4 * q + 2], x[4 * q + 3]}; } }
}
__device__ __forceinline__ void combine_pass(const Frame& F, int l, float ysc) {
    const LAS int* pblk = (const LAS int*)(F.lds + RING_BYTES + 4096) + 32;
    const int pstart = (F.lane < 32) ? (pblk[F.lane & 31] << 8) : 0;
    int t = F.gw;
    for (; t + 3 * F.NGW < M; t += 4 * F.NGW) combine_tokens<4>(F, l, t, F.NGW, ysc, pstart);
    for (; t < M; t += F.NGW) combine_tokens<1>(F, l, t, F.NGW, ysc, pstart);
}

__device__ __forceinline__ Frame mkframe(unsigned char* lds_raw) {
    Frame F;
    F.lds = (LAS unsigned char*)lds_raw;
    F.MISC = (volatile LAS unsigned*)(F.lds + MISC_OFF);
    F.tid = tid_now(); F.lane = F.tid & 63; F.wave = __builtin_amdgcn_readfirstlane(F.tid >> 6);
    int bx = blockIdx.x; asm volatile("" : "+s"(bx));
    F.bx = bx; F.G = kernarg_G(); F.vcu = (F.G % 8 == 0) ? (bx % 8) * (F.G / 8) + bx / 8 : bx;
    F.gw = F.vcu * NWAVES + F.wave; F.NGW = F.G * NWAVES;
    F.ws = ARG_WS; F.X = ARG_OUT;
    return F;
}
__device__ __forceinline__ void grid_bar(unsigned char* lds_raw) {
    XcdBarrier b; b.bar = (unsigned*)(ARG_WS + WS_CTL) + CW_BAR; b.x = xb_xcc_id(); b.st = (volatile LAS unsigned*)((LAS unsigned char*)lds_raw + MISC_OFF) + 8;
    xcd_barrier(b);
}
#define GRID_BAR() do { grid_bar(lds_raw); if ((PROBE_MASK >> 20) & 1) grid_bar(lds_raw); } while (0)
#define WSP(T, off) ((T*)(F.ws + (off)))
#define WLP(off) ((const bf16*)(F.ws + WS_W + (size_t)l * 57 * MiB + (off)))

#define ATTN_UNIT(DQK, MASK, PUB, NR, LDS, W) do { if (NR) attn_unit<DQK, MASK, true, PUB, true>(LDS, W); else attn_unit<DQK, MASK, true, PUB, false>(LDS, W); } while (0)
template <int l> __device__ __forceinline__ void layer_body(unsigned char* lds_raw) {
        REP(1)
        {   const Frame F = mkframe(lds_raw);
            pg8::Gemm g{WSP(bf16, WS_XB), WLP(WL_IN), M, UW, D, D, D}; pg8::StaticOrder S; S.init(M, UW, F.G, F.bx);
            pg8::EpiU E{WSP(bf16, WS_U), UW, WSP(float, WS_STQ), WSP(float, WS_STKV), WSP(float, WS_STX), EPS, M};
            pg8::gemm_phase<pg8::EpiU, pg8::StaticOrder, PG8_ALIGN, PG8_SP2>(F.lds + RING_OFF, g, S, E); }
        if (l == 0) {
            const Frame F = mkframe(lds_raw);
            pg8::Gemm g{WSP(bf16, WS_MN), WSP(bf16, WS_XKV), MM, 1024, D, D, D}; pg8::StaticOrder S; S.init(MM, 1024, F.G, F.bx);
            pg8::EpiPlainBf16 E{WSP(bf16, WS_KVX), 1024};
            pg8::gemm_phase<pg8::EpiPlainBf16, pg8::StaticOrder, PG8_ALIGN, PG8_SP2>(F.lds + RING_OFF, g, S, E); }
        GRID_BAR();
        REP(2)
        {   const Frame F = mkframe(lds_raw);
            pg8::Gemm g{WSP(bf16, WS_U), WLP(WL_UP), M, 1024, 384, UW, 384}; pg8::StaticOrder S; S.init(M, 1024, F.G, F.bx);
            pg8::EpiScaleBf16 E{WSP(bf16, WS_QKV), 1024, WSP(float, WS_STQ), WSP(float, WS_STKV), 2, 4, 4, 1.0f / 256.0f, 1.0f / 128.0f, EPS, M};
            pg8::gemm_phase<pg8::EpiScaleBf16, pg8::StaticOrder, PG8_ALIGN, PG8_SP2>(F.lds + RING_OFF, g, S, E); }
        GRID_BAR();
        REP(3)
        {   const Frame F = mkframe(lds_raw);
            t3_pass(F, l, rep_ != 0);
            if (l == 0 && rep_ == 0) kx_norm_pass(F); }
        GRID_BAR();
        {   const Frame F = mkframe(lds_raw);
            bf16* QKV = WSP(bf16, WS_QKV); bf16* Y = WSP(bf16, WS_Y); bf16* U = WSP(bf16, WS_U);
            const float* mgq = (const float*)ARGP(9) + l * 96; const int* positions = (const int*)ARGP(2); const float* sgq = (const float*)ARGP(13) + l * 64;
            const float mla_kb = wave_absmax((const float*)ARGP(10) + l * 96, 96, F.lane) * 9.9f, swa_kb = wave_absmax((const float*)ARGP(14) + l * 64, 64, F.lane) * 8.08f;
            const float* sinks = (const float*)ARGP(15) + l * 4;
            const bool nr_mla = (wave_absmax(mgq, 96, F.lane) * 9.9f * (0.10206207261596575f * LOG2E) * mla_kb <= 64.0f);
            const bool nr_swa = (wave_absmax(sgq, 64, F.lane) * 8.08f * (0.125f * LOG2E) * swa_kb <= 64.0f) && (wave_absmax(sinks, 4, F.lane) * LOG2E <= 64.0f);
            REP(4)
            for (int j = F.vcu; j < 512; j += F.G) {
                const int bh = (j & 255) >> 3, qb = (j < 256) ? (j & 7) : 15 - (j & 7), b = bh >> 2, h = bh & 3;
                const size_t row0 = (size_t)b * SEQ;
                AttnWave W;
                W.Q = QKV + (row0 + 256 * qb + 32 * F.wave) * 1024 + 96 * h; W.ldq = 1024;
                W.O = Y + (row0 + 256 * qb + 32 * F.wave) * 1024 + 64 * h; W.ldo = 1024;
                W.K0 = QKV + row0 * 1024 + QC_KV + 128 * h; W.K1 = QKV + row0 * 1024 + QC_KR + 32 * h; W.ldk = 1024;
                W.V = QKV + row0 * 1024 + QC_KV + 128 * h + 64; W.ldv = 1024;
                W.NT = 4 * (qb + 1); W.qpos0 = 256 * qb + 32 * F.wave; W.sink = -INFINITY; W.qgain = mgq; W.qscale = 0.10206207261596575f * LOG2E; W.pos = positions + row0 + 256 * qb + 32 * F.wave; W.st = WSP(float, WS_STQ) + (row0 + 256 * qb + 32 * F.wave) * 4 + h; W.kbound = mla_kb; W.oflag = nullptr;
                ATTN_UNIT(96, 1, false, nr_mla, F.lds + RING_OFF, W);
            }
            REP(16)
            for (int j = F.vcu; j < 512; j += F.G) {
                const int b = j >> 6, kvh = (j >> 5) & 1, n = j & 31, g = F.wave >> 2, h = 2 * kvh + g;
                const size_t row0 = (size_t)b * SEQ; const int kstart = (n > 0) ? 128 * (n - 1) : 0; const int qoff = 128 * n + 32 * (F.wave & 3);
                AttnWave W;
                W.Q = U + (row0 + qoff) * UW + UC_SQ + 64 * h; W.ldq = UW;
                W.O = Y + (row0 + qoff) * 1024 + 256 + 64 * h; W.ldo = 1024;
                W.K0 = U + (row0 + kstart) * UW + UC_SK + 64 * kvh; W.K1 = W.K0; W.ldk = UW;
                W.V = U + (row0 + kstart) * UW + UC_SV + 64 * kvh; W.ldv = UW;
                W.NT = (n > 0) ? 4 : 2; W.qpos0 = qoff - kstart; W.sink = sinks[h] * LOG2E; W.qgain = sgq; W.qscale = 0.125f * LOG2E; W.pos = nullptr; W.st = WSP(float, WS_STKV) + (row0 + qoff) * 4 + h; W.kbound = swa_kb; W.oflag = nullptr;
                ATTN_UNIT(64, 2, false, nr_swa, F.lds + RING_OFF, W);
            }
        }
        GRID_BAR();
        REP(6)
        {   const Frame F = mkframe(lds_raw);
            pg8::Gemm g{WSP(bf16, WS_Y), WLP(WL_MIX), M, D, D, D, D}; pg8::StaticOrder S; S.init(M, D, F.G, F.bx);
            LAS float* tbl = (LAS float*)(F.lds + RING_BYTES + 4096); const float* SA = WSP(float, WS_STQ); const float* SC = WSP(float, WS_STKV);
            for (int i = 0; i < 4; ++i) { pg8::Unit u; if (!S.next(i, u)) break;
                if (F.tid < 256) { const size_t row = (size_t)u.pm * 256 + F.tid; const f32x4 a4 = *(const GAS f32x4*)(SA + row * 4), c4 = *(const GAS f32x4*)(SC + row * 4);
                    const float ra = __builtin_amdgcn_rsqf(((a4[0] + a4[1]) + (a4[2] + a4[3])) * (1.0f / 256.0f) + EPS), rc = __builtin_amdgcn_rsqf(((c4[0] + c4[1]) + (c4[2] + c4[3])) * (1.0f / 256.0f) + EPS);
                    tbl[(i * 256 + F.tid) * 2] = ra / rc; tbl[(i * 256 + F.tid) * 2 + 1] = rc; } }
            __syncthreads();
            pg8::EpiResMix E{WSP(bf16, WS_XB), D, WSP(float, WS_STX), M, tbl};
            pg8::gemm_phase<pg8::EpiResMix, pg8::StaticOrder, PG8_ALIGN, PG8_SP2>(F.lds + RING_OFF, g, S, E); }
        GRID_BAR();
        if (kernarg_G() == 256) {
        REP(7)
        {   const Frame F = mkframe(lds_raw);
            unsigned* QF = (unsigned*)(F.ws + WS_CTL) + CW_FQ + 8192 * l; unsigned* OF = (unsigned*)(F.ws + WS_CTL) + CW_FO + 8192 * l;
            const int half = F.bx >> 7;
            pg8::StaticOrderPub S; S.init(M, 256, F.G, F.bx & 127); S.flg = QF; S.lane = F.lane;
            pg8::Unit u0; (void)S.next(0, u0); const int pm = u0.pm;
            if (half == 0) {
                pg8::Gemm g{WSP(bf16, WS_XB), WLP(WL_XQ), M, 256, D, D, D};
                pg8::EpiScaleBf16WT E{WSP(bf16, WS_QX), 256, WSP(float, WS_STX), WSP(float, WS_STX), 1, 16, 16, 1.0f / 1024.0f, 1.0f / 1024.0f, EPS, M};
                pg8::gemm_phase<pg8::EpiScaleBf16WT, pg8::StaticOrderPub, PG8_ALIGN, PG8_SP2>(F.lds + RING_OFF, g, S, E);
            } else { prep_experts<0>(F, l, (F.bx - 128) * NWAVES + F.wave, 128 * NWAVES);
                if (l == 0) {
                    prep_weights<false>(F, 1, 1, IT_GU + IT_DN, IT_O_POOL, (F.bx - 128) * NWAVES + F.wave, 128 * NWAVES);
                    prep_weights<false>(F, 1, 1, IT_O_POOL + IT_POOL, IT_O_XKV, (F.bx - 128) * NWAVES + F.wave, 128 * NWAVES);
                    prep_weights<false>(F, 1, 1, IT_O_XKV + IT_XKV, IT_LAYER, (F.bx - 128) * NWAVES + F.wave, 128 * NWAVES); } }
            {   bf16* QX = WSP(bf16, WS_QX); bf16* OX = WSP(bf16, WS_OX); bf16* KVX = WSP(bf16, WS_KVX);
                const float* xgq = (const float*)ARGP(24) + l * 64;
                const float x_kb = wave_absmax((const float*)ARGP(25) + l * 64, 64, F.lane) * 8.08f;
                const bool nr_x = (wave_absmax(xgq, 64, F.lane) * 8.08f * (0.125f * LOG2E) * x_kb <= 64.0f);
                pg8::flag_wait_wg(QF + 64 * pm, 8u);
                for (int hh = 0; hh < 2; ++hh) {
                    const int b = pm >> 4, h = 2 * half + hh, qb = pm & 15;
                    const size_t row0 = (size_t)b * SEQ + 256 * qb + 32 * F.wave;
                    AttnWave W;
                    W.Q = QX + row0 * 256 + 64 * h; W.ldq = 256; W.O = OX + row0 * 256 + 64 * h; W.ldo = 256;
                    W.K0 = KVX + (size_t)(b * MEMLEN) * 1024 + 512 * l + 64 * h; W.K1 = W.K0; W.ldk = 1024;
                    W.V = W.K0 + 256; W.ldv = 1024;
                    W.NT = 4; W.qpos0 = 0; W.sink = -INFINITY; W.qgain = xgq; W.qscale = 0.125f * LOG2E; W.pos = nullptr; W.st = nullptr; W.kbound = x_kb; W.oflag = OF + 64 * pm;
                    ATTN_UNIT(64, 0, true, nr_x, F.lds + RING_OFF, W);
                } }
            {   pg8::flag_wait_wg(OF + 64 * pm, 32u);
                pg8::Gemm g{WSP(bf16, WS_OX), WLP(WL_XO), M, D, 256, 256, 256}; pg8::PairOrder S9{pm, 2 * half};
                pg8::EpiRes E{WSP(bf16, WS_XB), D, WSP(float, WS_STX), M};
                pg8::gemm_phase<pg8::EpiRes, pg8::PairOrder, PG8_ALIGN, PG8_SP2>(F.lds + RING_OFF, g, S9, E); } }
        } else {
        REP(7)
        {   const Frame F = mkframe(lds_raw);
            pg8::Gemm g{WSP(bf16, WS_XB), WLP(WL_XQ), M, 256, D, D, D}; pg8::StaticOrder S; S.init(M, 256, F.G, F.bx);
            pg8::EpiScaleBf16 E{WSP(bf16, WS_QX), 256, WSP(float, WS_STX), WSP(float, WS_STX), 1, 16, 16, 1.0f / 1024.0f, 1.0f / 1024.0f, EPS, M};
            if (F.G == 256 && F.bx >= 128) prep_experts<0>(F, l, (F.bx - 128) * NWAVES + F.wave, 128 * NWAVES);
            else {
            pg8::gemm_phase<pg8::EpiScaleBf16, pg8::StaticOrder, PG8_ALIGN, PG8_SP2>(F.lds + RING_OFF, g, S, E);
            if (F.G != 256) prep_experts<0>(F, l, F.gw, F.NGW); } }
        GRID_BAR();
        REP(8)
        {   const Frame F = mkframe(lds_raw);
            bf16* QX = WSP(bf16, WS_QX); bf16* OX = WSP(bf16, WS_OX); bf16* KVX = WSP(bf16, WS_KVX);
            const float* xgq = (const float*)ARGP(24) + l * 64;
            const float x_kb = wave_absmax((const float*)ARGP(25) + l * 64, 64, F.lane) * 8.08f;
            const bool nr_x = (wave_absmax(xgq, 64, F.lane) * 8.08f * (0.125f * LOG2E) * x_kb <= 64.0f);
            for (int j = F.vcu; j < 512; j += F.G) {
                const int b = j >> 6, h = (j >> 4) & 3, qb = j & 15;
                const size_t row0 = (size_t)b * SEQ + 256 * qb + 32 * F.wave;
                AttnWave W;
                W.Q = QX + row0 * 256 + 64 * h; W.ldq = 256; W.O = OX + row0 * 256 + 64 * h; W.ldo = 256;
                W.K0 = KVX + (size_t)(b * MEMLEN) * 1024 + 512 * l + 64 * h; W.K1 = W.K0; W.ldk = 1024;
                W.V = W.K0 + 256; W.ldv = 1024;
                W.NT = 4; W.qpos0 = 0; W.sink = -INFINITY; W.qgain = xgq; W.qscale = 0.125f * LOG2E; W.pos = nullptr; W.st = nullptr; W.kbound = x_kb; W.oflag = nullptr;
                ATTN_UNIT(64, 0, false, nr_x, F.lds + RING_OFF, W);
            }
        }
        GRID_BAR();
        REP(9)
        {   const Frame F = mkframe(lds_raw);
            pg8::Gemm g{WSP(bf16, WS_OX), WLP(WL_XO), M, D, 256, 256, 256}; pg8::StaticOrder S; S.init(M, D, F.G, F.bx);
            pg8::EpiRes E{WSP(bf16, WS_XB), D, WSP(float, WS_STX), M};
            pg8::gemm_phase<pg8::EpiRes, pg8::StaticOrder, PG8_ALIGN, PG8_SP2>(F.lds + RING_OFF, g, S, E); }
        }
        GRID_BAR();
        REP(11)
        {   const Frame F = mkframe(lds_raw);
            route_pass(F, l); }
        GRID_BAR();
        REP(13)
        {   const Frame F = mkframe(lds_raw);
            LAS int* gidx = (LAS int*)(F.lds + RING_BYTES); LAS int* cnt = (LAS int*)(F.lds + RING_BYTES + 4096); LAS int* pblk = cnt + 32; LAS int* bexp = pblk + 40;
            const int nused = moe_tables(F, l, cnt, pblk, bexp);
            { const int* TOKR = WSP(int, WS_TOKR); const float* RSR = WSP(float, WS_RSR); const float* WR = WSP(float, WS_WR); float* RSLOT = WSP(float, WS_RSLOT); float* WSLOT = WSP(float, WS_WSLOT);
              int tk[4]; float rsv[4], wv[4];
#pragma unroll
              for (int i = 0; i < 4; ++i) { const int L = i * F.G + F.vcu; tk[i] = 0; rsv[i] = 0.f; wv[i] = 0.f;
                if (L < (nused << 1) && F.tid < 256) { const int pm = L >> 1, e = bexp[pm], rk = (pm - pblk[e]) * 256 + F.tid; const size_t q = (size_t)e * ECAP + rk;
                    if (rk < cnt[e]) { tk[i] = TOKR[q]; rsv[i] = RSR[q]; wv[i] = WR[q]; } } }
#pragma unroll
              for (int i = 0; i < 4; ++i) { const int L = i * F.G + F.vcu;
                if (L < (nused << 1) && F.tid < 256) { const int pm = L >> 1; gidx[i * 256 + F.tid] = tk[i]; RSLOT[pm * 256 + F.tid] = rsv[i]; WSLOT[pm * 256 + F.tid] = wv[i]; } } }
            __syncthreads();
            pg8::Gemm g{WSP(bf16, WS_XB), WLP(WL_GU), PSLOTS, NEXP * 512, D, D, D};
            const int RG = ((nused << 1) / F.G) * F.G;
            pg8::MoeOrder S{(const int*)bexp, RG, F.G, F.vcu, 1};
            pg8::EpiSwiglu E{WSP(bf16, WS_H), 256, WSP(float, WS_RSLOT)};
            pg8::gemm_phase<pg8::EpiSwiglu, pg8::MoeOrder, PG8_ALIGN, PG8_SP2, true>(F.lds + RING_OFF, g, S, E, gidx); }
        GRID_BAR();
        REP(14)
        {   const Frame F = mkframe(lds_raw);
            LAS int* gidx = (LAS int*)(F.lds + RING_BYTES); LAS int* cnt = (LAS int*)(F.lds + RING_BYTES + 4096); LAS int* pblk = cnt + 32; LAS int* bexp = pblk + 40;
            const int nused = (rep_ == 0) ? pblk[32] : moe_tables(F, l, cnt, pblk, bexp);
            const int RG = ((nused << 1) / F.G) * F.G, T = (nused << 1) - RG, mainblk = RG >> 1;
            unsigned* FLG = (unsigned*)(F.ws + WS_CTL) + CW_FLG + 16384 * l;
            if (F.vcu < T) {
                const int L0 = RG + F.vcu; gidx += (RG / F.G) * 256;
                pg8::Gemm gu{WSP(bf16, WS_XB), WLP(WL_GU), PSLOTS, NEXP * 512, D, D, D};
                pg8::MoeTailOrder ST{(const int*)bexp, L0, mainblk, FLG, F.lane};
                pg8::EpiSwigluWT EU{WSP(bf16, WS_H), 256, WSP(float, WS_RSLOT)};
                pg8::gemm_phase<pg8::EpiSwigluWT, pg8::MoeTailOrder, PG8_ALIGN, PG8_SP2, true>(F.lds + RING_OFF, gu, ST, EU, gidx); }
            pg8::Gemm g{WSP(bf16, WS_H), WLP(WL_DN), PSLOTS, NEXP * 1024, 256, 256, 256};
            pg8::MoeOrderY S{(const int*)bexp, nused << 2, F.G, F.vcu, T, 2, mainblk, RG, FLG, F.lane};
            pg8::EpiDown E{WSP(unsigned char, WS_YB), D, WSP(float, WS_WSLOT)};
            pg8::gemm_phase<pg8::EpiDown, pg8::MoeOrderY, PG8_ALIGN, PG8_SP2>(F.lds + RING_OFF, g, S, E); }
        GRID_BAR();
        REP(15)
        {   const Frame F = mkframe(lds_raw); combine_pass(F, l, rep_ == 0 ? 1.0f : 0.0f); }
}

__global__ void __launch_bounds__(NTHR, 2) fwd_megakernel(Args A_unused) {
    extern __shared__ __attribute__((aligned(16))) unsigned char lds_raw[];
    {
        const int tid = threadIdx.x;
        for (int u = tid; u < (LDS_BYTES - LDSCTL_OFF) / 4; u += NTHR) ((LAS unsigned*)((LAS unsigned char*)lds_raw + LDSCTL_OFF))[u] = 0u;
        __syncthreads();
        (void)xcd_barrier_post((unsigned*)(ARG_WS + WS_CTL) + CW_BAR, (volatile LAS unsigned*)((LAS unsigned char*)lds_raw + MISC_OFF) + 8);
    }
    REP(0)
    {   const Frame F = mkframe(lds_raw);
        if (kernarg_G() == 256) { prep_weights(F, 0, 1, IT_GU + IT_DN, IT_LAYER, F.gw, F.NGW); prep_weights(F, 1, 1, IT_O_POOL, IT_O_POOL + IT_POOL, F.gw, F.NGW); prep_weights<false>(F, 1, 1, IT_O_XKV, IT_O_XKV + IT_XKV, F.gw, F.NGW); }
        else prep_weights(F, 0, NL, IT_GU + IT_DN, IT_LAYER, F.gw, F.NGW);
        rows_pass<false>(F, (const float*)ARGP(0), WSP(bf16, WS_XB), WSP(float, WS_STX), M);
        rows_pass<true>(F, (const float*)ARGP(1), WSP(bf16, WS_MN), nullptr, MM);
    }
    GRID_BAR();

    layer_body<0>(lds_raw);
    GRID_BAR();
    layer_body<1>(lds_raw);
}

extern "C" void kernel_launch(void* const* d_in, const int* in_sizes, int n_in, void* d_out, int out_size, void* d_ws, size_t ws_size, hipStream_t stream) {
    static int grid = 0;
    if (grid == 0) {
        if (n_in != 35 || out_size != M * D || ws_size < WS_END) { fprintf(stderr, "kernel_launch: unexpected shapes (n_in %d, out %d, ws %zu)\n", n_in, out_size, ws_size); grid = -1; return; }
        int dev = 0, cus = 0;
        if (hipGetDevice(&dev) != hipSuccess || hipDeviceGetAttribute(&cus, hipDeviceAttributeMultiprocessorCount, dev) != hipSuccess) { grid = -1; return; }
        if (hipFuncSetAttribute((const void*)fwd_megakernel, hipFuncAttributeMaxDynamicSharedMemorySize, LDS_BYTES) != hipSuccess) { fprintf(stderr, "kernel_launch: hipFuncSetAttribute failed\n"); grid = -1; return; }
        grid = cus;
    }
    if (grid < 0) return;
    (void)hipMemsetAsync((char*)d_ws + WS_CTL, 0, CTL_ZERO_BYTES, stream);
    Args a{};
    for (int i = 0; i < 35; ++i) a.in[i] = d_in[i];
    a.out = (float*)d_out; a.ws = (unsigned char*)d_ws; a.G = grid; a.pad = 0;
    hipLaunchKernelGGL(fwd_megakernel, dim3(grid), dim3(NTHR), LDS_BYTES, stream, a);
}
```
